# Optimizing an MI355X kernel written in HIP

```python
import math
import jax, jax.numpy as jnp
from jax import lax
import numpy as np

D_MODEL = 1024
BATCH = 2
SEQ = 8192
DEPTH = 1

N_META = 16
D_MIX = D_MODEL
RET_HEADS = 4
RET_HEAD_DIM = 128
RET_WIDTH = RET_HEADS * RET_HEAD_DIM
SSM_WIDTH = D_MIX - RET_WIDTH
SSM_GROUP = 16
SSM_GROUPS = SSM_WIDTH // SSM_GROUP
SSM_STATE = 64
CHUNK = 128
D_FF = 2816
FFN_RES = 0.5
ROPE_BASE = 10000.0
EPS = 1e-6
IN_PROJ = 4 * RET_WIDTH + SSM_WIDTH

kernel_name = "hymba_retnet_s5_macaron_layer"


def rms_norm(x, w):
    xf = x.astype(jnp.float32)
    y = xf * lax.rsqrt(jnp.mean(xf * xf, axis=-1, keepdims=True) + EPS)
    return (y * w.astype(jnp.float32)).astype(x.dtype)


def swiglu(x, w_gate, w_up, w_down):
    return (jax.nn.silu(x @ w_gate) * (x @ w_up)) @ w_down


def rotary(x, pos):
    dh = x.shape[-1]
    freqs = 1.0 / (ROPE_BASE ** (jnp.arange(0, dh, 2, dtype=jnp.float32) / dh))
    ang = pos.astype(jnp.float32)[:, None] * freqs[None, :]
    cos = jnp.cos(ang)[None, :, None, :]
    sin = jnp.sin(ang)[None, :, None, :]
    xf = x.astype(jnp.float32)
    x1, x2 = xf[..., : dh // 2], xf[..., dh // 2:]
    out = jnp.concatenate([x1 * cos - x2 * sin, x1 * sin + x2 * cos], axis=-1)
    return out.astype(x.dtype)


def retention(q, k, v):
    bsz, L, H, dk = q.shape
    dv = v.shape[-1]
    log_g = jnp.log(1.0 - 2.0 ** (-5.0 - jnp.arange(H, dtype=jnp.float32)))

    def decay_mask(n):
        i = jnp.arange(n)
        diff = i[:, None] - i[None, :]
        return jnp.where(diff[None] >= 0,
                         jnp.exp(log_g[:, None, None] * jnp.maximum(diff, 0)[None].astype(jnp.float32)),
                         0.0)

    qm, km, vm = q[:, :N_META], k[:, :N_META], v[:, :N_META]
    s_m = jnp.einsum('bihd,bjhd->bhij', qm, km) * decay_mask(N_META)
    o_meta = jnp.einsum('bhij,bjhe->bihe', s_m, vm)
    w_m = jnp.exp(log_g[:, None] * (N_META - 1 - jnp.arange(N_META, dtype=jnp.float32))[None])
    state0 = jnp.einsum('bjhd,bjhe,hj->bhde', km, vm, w_m)

    n_chunks = (L - N_META) // CHUNK
    qc = q[:, N_META:].reshape(bsz, n_chunks, CHUNK, H, dk)
    kc = k[:, N_META:].reshape(bsz, n_chunks, CHUNK, H, dk)
    vc = v[:, N_META:].reshape(bsz, n_chunks, CHUNK, H, dv)
    s_c = jnp.einsum('bnihd,bnjhd->bnhij', qc, kc) * decay_mask(CHUNK)
    o_inner = jnp.einsum('bnhij,bnjhe->bnihe', s_c, vc)
    pos_c = jnp.arange(CHUNK, dtype=jnp.float32)
    w_k = jnp.exp(log_g[:, None] * (CHUNK - 1 - pos_c)[None])
    kv = jnp.einsum('bnjhd,bnjhe,hj->nbhde', kc, vc, w_k)
    g_chunk = jnp.exp(log_g * CHUNK)[None, :, None, None]
    state0 = state0.astype(kv.dtype)

    def step(S, kv_n):
        return (g_chunk * S + kv_n).astype(kv_n.dtype), S

    _, s_prev = lax.scan(step, state0, kv)
    w_q = jnp.exp(log_g[:, None] * (pos_c + 1.0)[None])
    o_cross = jnp.einsum('bnihd,nbhde,hi->bnihe', qc, s_prev, w_q)
    o_real = (o_inner + o_cross).reshape(bsz, L - N_META, H, dv)
    return jnp.concatenate([o_meta, o_real.astype(o_meta.dtype)], axis=1)


def head_group_norm(o, w):
    of = o.astype(jnp.float32)
    mu = jnp.mean(of, axis=-1, keepdims=True)
    var = jnp.mean(jnp.square(of - mu), axis=-1, keepdims=True)
    y = (of - mu) * lax.rsqrt(var + EPS)
    y = y.reshape(o.shape[0], o.shape[1], -1) * w.astype(jnp.float32)
    return y


def _linear_recurrence(e1, e2):
    a1, b1 = e1
    a2, b2 = e2
    return a1 * a2, a2 * b1 + b2


def s5_mixer(u, lam_re, lam_im, log_dt, b_re, b_im, c_re, c_im, d, glu_w, glu_b, norm_w):
    bsz, L, _ = u.shape
    uf = u.astype(jnp.float32).reshape(bsz, L, SSM_GROUPS, SSM_GROUP)
    lam = lax.complex(lam_re.astype(jnp.float32), lam_im.astype(jnp.float32))
    dt = jnp.exp(log_dt.astype(jnp.float32))[:, None]
    a_bar = jnp.exp(lam * dt)
    b = lax.complex(b_re.astype(jnp.float32), b_im.astype(jnp.float32))
    b_bar = ((a_bar - 1.0) / lam)[..., None] * b
    bu = jnp.einsum('gnp,blgp->blgn', b_bar, uf.astype(jnp.complex64))
    a = jnp.broadcast_to(a_bar[None, None], bu.shape)
    _, states = lax.associative_scan(_linear_recurrence, (a, bu), axis=1)
    c = lax.complex(c_re.astype(jnp.float32), c_im.astype(jnp.float32))
    y = jnp.real(jnp.einsum('gpn,blgn->blgp', c, states))
    y = y + d.astype(jnp.float32).reshape(SSM_GROUPS, SSM_GROUP) * uf
    y = jax.nn.gelu(y.reshape(bsz, L, SSM_WIDTH)).astype(u.dtype)
    y = y * jax.nn.sigmoid(y @ glu_w + glu_b)
    return rms_norm(y, norm_w)


def setup_inputs(seed: int = 0) -> dict:
    key = jax.random.key(seed)
    ks = jax.random.split(key, 32)
    f32 = jnp.float32
    nrm = lambda k, shape, scale: (jax.random.normal(k, shape, f32) * scale)
    gain = lambda k, shape: 1.0 + 0.01 * jax.random.normal(k, shape, f32)
    Ld = DEPTH
    n_idx = jnp.arange(SSM_STATE, dtype=f32)
    return {
        "x": nrm(ks[0], (BATCH, SEQ, D_MODEL), 1.0),
        "meta_tokens": nrm(ks[1], (N_META, D_MODEL), 1.0),
        "ffn1_norm_w": gain(ks[2], (Ld, D_MODEL)),
        "ffn1_w_gate": nrm(ks[3], (Ld, D_MODEL, D_FF), D_MODEL ** -0.5),
        "ffn1_w_up": nrm(ks[4], (Ld, D_MODEL, D_FF), D_MODEL ** -0.5),
        "ffn1_w_down": nrm(ks[5], (Ld, D_FF, D_MODEL), D_FF ** -0.5),
        "mix_norm_w": gain(ks[6], (Ld, D_MODEL)),
        "w_in": nrm(ks[7], (Ld, D_MODEL, IN_PROJ), D_MODEL ** -0.5),
        "ret_norm_w": gain(ks[8], (Ld, RET_WIDTH)),
        "ssm_lambda_re": -0.5 + 0.01 * jax.random.normal(ks[9], (Ld, SSM_GROUPS, SSM_STATE), f32),
        "ssm_lambda_im": jnp.pi * n_idx[None, None, :] + 0.01 * jax.random.normal(ks[10], (Ld, SSM_GROUPS, SSM_STATE), f32),
        "ssm_log_dt": jax.random.uniform(ks[11], (Ld, SSM_GROUPS), f32, minval=math.log(0.001), maxval=math.log(0.1)),
        "ssm_b_re": nrm(ks[12], (Ld, SSM_GROUPS, SSM_STATE, SSM_GROUP), (2.0 * SSM_GROUP) ** -0.5),
        "ssm_b_im": nrm(ks[13], (Ld, SSM_GROUPS, SSM_STATE, SSM_GROUP), (2.0 * SSM_GROUP) ** -0.5),
        "ssm_c_re": nrm(ks[14], (Ld, SSM_GROUPS, SSM_GROUP, SSM_STATE), (2.0 * SSM_STATE) ** -0.5),
        "ssm_c_im": nrm(ks[15], (Ld, SSM_GROUPS, SSM_GROUP, SSM_STATE), (2.0 * SSM_STATE) ** -0.5),
        "ssm_d": nrm(ks[16], (Ld, SSM_WIDTH), 1.0),
        "ssm_glu_w": nrm(ks[17], (Ld, SSM_WIDTH, SSM_WIDTH), SSM_WIDTH ** -0.5),
        "ssm_glu_b": nrm(ks[18], (Ld, SSM_WIDTH), 0.01),
        "ssm_norm_w": gain(ks[19], (Ld, SSM_WIDTH)),
        "w_out": nrm(ks[20], (Ld, D_MIX, D_MODEL), D_MIX ** -0.5),
        "ffn2_norm_w": gain(ks[21], (Ld, D_MODEL)),
        "ffn2_w_gate": nrm(ks[22], (Ld, D_MODEL, D_FF), D_MODEL ** -0.5),
        "ffn2_w_up": nrm(ks[23], (Ld, D_MODEL, D_FF), D_MODEL ** -0.5),
        "ffn2_w_down": nrm(ks[24], (Ld, D_FF, D_MODEL), D_FF ** -0.5),
        "final_norm_w": gain(ks[25], (D_MODEL,)),
    }


def reference(x, meta_tokens, ffn1_norm_w, ffn1_w_gate, ffn1_w_up, ffn1_w_down, mix_norm_w,
              w_in, ret_norm_w, ssm_lambda_re, ssm_lambda_im, ssm_log_dt, ssm_b_re, ssm_b_im,
              ssm_c_re, ssm_c_im, ssm_d, ssm_glu_w, ssm_glu_b, ssm_norm_w, w_out,
              ffn2_norm_w, ffn2_w_gate, ffn2_w_up, ffn2_w_down, final_norm_w):
    bsz = x.shape[0]
    meta = jnp.broadcast_to(meta_tokens.astype(x.dtype)[None], (bsz, N_META, D_MODEL))
    h = jnp.concatenate([meta, x], axis=1)
    L = h.shape[1]
    pos = jnp.arange(L)
    for l in range(DEPTH):
        h = h + FFN_RES * swiglu(rms_norm(h, ffn1_norm_w[l]), ffn1_w_gate[l], ffn1_w_up[l], ffn1_w_down[l])
        n = rms_norm(h, mix_norm_w[l])
        proj = n @ w_in[l]
        q = proj[..., 0:RET_WIDTH].reshape(bsz, L, RET_HEADS, RET_HEAD_DIM)
        k = proj[..., RET_WIDTH:2 * RET_WIDTH].reshape(bsz, L, RET_HEADS, RET_HEAD_DIM)
        v = proj[..., 2 * RET_WIDTH:3 * RET_WIDTH].reshape(bsz, L, RET_HEADS, RET_HEAD_DIM)
        g = proj[..., 3 * RET_WIDTH:4 * RET_WIDTH]
        u = proj[..., 4 * RET_WIDTH:]
        q = rotary(q, pos)
        k = rotary(k, pos) * (RET_HEAD_DIM ** -0.5)
        ret = head_group_norm(retention(q, k, v), ret_norm_w[l])
        ret = (jax.nn.silu(g.astype(jnp.float32)) * ret).astype(x.dtype)
        ssm = s5_mixer(u, ssm_lambda_re[l], ssm_lambda_im[l], ssm_log_dt[l], ssm_b_re[l], ssm_b_im[l],
                       ssm_c_re[l], ssm_c_im[l], ssm_d[l], ssm_glu_w[l], ssm_glu_b[l], ssm_norm_w[l])
        mixed = jnp.concatenate([ret, ssm.astype(x.dtype)], axis=-1) @ w_out[l]
        h = h + mixed
        h = h + FFN_RES * swiglu(rms_norm(h, ffn2_norm_w[l]), ffn2_w_gate[l], ffn2_w_up[l], ffn2_w_down[l])
    out = rms_norm(h, final_norm_w)
    return out[:, N_META:]
```

```cpp
#include <hip/hip_runtime.h>
#include <hip/hip_cooperative_groups.h>
#include <cstdio>
#include <cstdint>
namespace cg = cooperative_groups;
namespace pg8 {
#define PG8_LAS __attribute__((address_space(3)))
typedef unsigned short bf16_t;
typedef short bf16x8 __attribute__((ext_vector_type(8)));
typedef float f32x4 __attribute__((ext_vector_type(4)));
typedef unsigned u32x4 __attribute__((ext_vector_type(4)));
constexpr int BM = 256, BK = 64, HALF = 128, HTB = HALF * BK * 2  , STAGE_BYTES = 8 * HTB, NXCD = 8, WGM = 8;

__host__ __device__ __forceinline__ int lds_byte(int r, int c) { const int st = (r >> 4) * 2 + (c >> 5), rr = r & 15, cc = c & 31, ob = rr * 64 + cc * 2; return st * 1024 + (ob ^ (((ob >> 9) & 1) << 5)); }
__host__ __device__ __forceinline__ void stage_rc(int b, int& R, int& C) { const int st = b / 1024, sb = b % 1024, swz = sb ^ (((sb >> 9) & 1) << 5); R = (st >> 1) * 16 + swz / 64; C = (st & 1) * 32 + (swz % 64) / 2; }
__host__ __device__ __forceinline__ int perm32(int rho) { const int n = rho >> 4, i = rho & 15; return 8 * (i >> 2) + 4 * n + (i & 3); }

struct Unit { int pm, pn; };
struct Gemm { const bf16_t* A; const bf16_t* Bt; int K, lda, ldb; };

struct StaticOrder {
    int nM, nN, nwg, G, c;
    __host__ __device__ void init(int M, int N, int G_, int c_) { nM = M / BM; nN = N / BM; nwg = nM * nN; G = G_; c = c_; }
    __host__ __device__ bool next(int i, Unit& u) const {
        const long L = (long)i * G + c; if (L >= nwg) return false;
        int wgid = (int)L; { const int q = nwg / NXCD, r = nwg % NXCD, xcd = wgid % NXCD, off = wgid / NXCD; wgid = (xcd < r ? xcd * (q + 1) : r * (q + 1) + (xcd - r) * q) + off; }
        const int nig = WGM * nN, gid = wgid / nig, fm = gid * WGM, gsz = (nM - fm) < WGM ? (nM - fm) : WGM;
        u.pm = fm + ((wgid % nig) % gsz); u.pn = (wgid % nig) / gsz; return true;
    }
    __device__ __forceinline__ void a_ready(const Unit&) const {}
    __device__ __forceinline__ void done(const Unit&) const {}
};

__device__ __forceinline__ unsigned cvt_pk_bf16(float lo, float hi) { unsigned r; asm volatile("v_cvt_pk_bf16_f32 %0, %1, %2" : "=v"(r) : "v"(lo), "v"(hi)); return r; }
template <class Epi, class Sched, bool ALIGN_EPI = false, bool SP2 = false>
__device__ __forceinline__ void gemm_phase(PG8_LAS unsigned char* lds, const Gemm g, const Sched& S, const Epi& E) {
    const int tid = threadIdx.x, wid = __builtin_amdgcn_readfirstlane(tid >> 6), lane = tid & 63, wr = wid >> 2, wc = wid & 3, fr = lane & 15, fq = lane >> 4;
    const int K = g.K, nt = K / BK;
    unsigned voffA[2], voffB[2];
#pragma unroll
    for (int i = 0; i < 2; ++i) { int R, C; stage_rc(tid * 16 + i * 8192, R, C); const int Rb = Epi::PERM ? ((R & ~31) + perm32(R & 31)) : R;
        voffA[i] = (unsigned)(R * g.lda + C) * 2u; voffB[i] = (unsigned)(Rb * g.ldb + C) * 2u; }
    const size_t kstep = (size_t)(BK * 2);
    const size_t hstepA = (size_t)HALF * g.lda * 2, hstepB = (size_t)HALF * g.ldb * 2;
    const size_t tstepA = 2 * hstepA, tstepB = 2 * hstepB;
    const unsigned ldsw = (unsigned)wid * 1024u;
    const int aoff = lds_byte(wr * 64 + fr, fq * 8), boff = lds_byte(wc * 32 + fr, fq * 8);
#define PG8_SA(b, h) (((b) * 2 + (h)) * HTB)
#define PG8_SB(b, h) ((4 + (b) * 2 + (h)) * HTB)
#define PG8_STAGE(bufoff, gbase, voff) do { _Pragma("unroll") for (int _i = 0; _i < 2; ++_i) \
        __builtin_amdgcn_global_load_lds((const unsigned*)((const char*)(gbase) + (voff)[_i]), (PG8_LAS unsigned*)(lds + (bufoff) + ldsw + _i * 8192), 16, 0, 0); } while (0)
#define PG8_LDA(dst, b, h) do { _Pragma("unroll") for (int m = 0; m < 4; ++m) _Pragma("unroll") for (int k = 0; k < 2; ++k) dst[m][k] = *(const PG8_LAS bf16x8*)(lds + PG8_SA(b, h) + aoff + m * 2048 + k * 1024); } while (0)
#define PG8_LDB(dst, b, h) do { _Pragma("unroll") for (int n = 0; n < 2; ++n) _Pragma("unroll") for (int k = 0; k < 2; ++k) dst[n][k] = *(const PG8_LAS bf16x8*)(lds + PG8_SB(b, h) + boff + n * 2048 + k * 1024); } while (0)
#define PG8_MMA(ai, bj, At, Bt) do { __builtin_amdgcn_s_setprio(1); _Pragma("unroll") for (int m = 0; m < 4; ++m) _Pragma("unroll") for (int n = 0; n < 2; ++n) _Pragma("unroll") for (int k = 0; k < 2; ++k) \
        acc[ai][bj][m][n] = __builtin_amdgcn_mfma_f32_16x16x32_bf16(Bt[n][k], At[m][k], acc[ai][bj][m][n], 0, 0, 0); __builtin_amdgcn_s_setprio(0); } while (0)
#define PG8_WAIT_V(n) asm volatile("s_waitcnt vmcnt(" #n ")" ::: "memory")
#define PG8_WAIT_L(n) asm volatile("s_waitcnt lgkmcnt(" #n ")" ::: "memory")
#define PG8_BAR __builtin_amdgcn_s_barrier()
#define PG8_SCHED __builtin_amdgcn_sched_barrier(0)
    Unit cur, nxt; int ui = 0;
    if (!S.next(0, cur)) return;
    f32x4 acc[2][2][4][2];
#pragma unroll
    for (int a = 0; a < 2; ++a)
#pragma unroll
        for (int b = 0; b < 2; ++b)
#pragma unroll
            for (int m = 0; m < 4; ++m)
#pragma unroll
                for (int n = 0; n < 2; ++n) acc[a][b][m][n] = (f32x4){0.f, 0.f, 0.f, 0.f};
    bf16x8 At[4][2], B0[2][2], B1[2][2];
    const char* cA = (const char*)g.A + (size_t)cur.pm * tstepA; const char* cB = (const char*)g.Bt + (size_t)cur.pn * tstepB;
    S.a_ready(cur);
    if constexpr (SP2) {
        PG8_STAGE(PG8_SB(0, 0), cB, voffB); PG8_STAGE(PG8_SB(0, 1), cB + hstepB, voffB); PG8_STAGE(PG8_SA(0, 0), cA, voffA); PG8_STAGE(PG8_SA(0, 1), cA + hstepA, voffA);
        if (wr == 1) PG8_BAR;
        PG8_WAIT_V(2); PG8_BAR;
        PG8_STAGE(PG8_SB(1, 0), cB + kstep, voffB); PG8_STAGE(PG8_SA(1, 0), cA + kstep, voffA); PG8_STAGE(PG8_SB(1, 1), cB + hstepB + kstep, voffB);
        PG8_WAIT_V(6); PG8_BAR;
    } else {
        PG8_STAGE(PG8_SB(0, 0), cB, voffB); PG8_STAGE(PG8_SA(0, 0), cA, voffA); PG8_STAGE(PG8_SB(0, 1), cB + hstepB, voffB); PG8_STAGE(PG8_SA(0, 1), cA + hstepA, voffA);
        if (wr == 1) PG8_BAR;
        PG8_WAIT_V(4); PG8_BAR;
        PG8_STAGE(PG8_SB(1, 0), cB + kstep, voffB); PG8_STAGE(PG8_SA(1, 0), cA + kstep, voffA); PG8_STAGE(PG8_SB(1, 1), cB + hstepB + kstep, voffB);
        PG8_WAIT_V(6); PG8_BAR;
    }
    for (;;) {
        const bool has_next = S.next(ui + 1, nxt);
        const char* nA = has_next ? (const char*)g.A + (size_t)nxt.pm * tstepA : cA; const char* nB = has_next ? (const char*)g.Bt + (size_t)nxt.pn * tstepB : cB;
        for (int t = 0; t < nt; t += 2) {
            if constexpr (Epi::HAS_MID) { if (t == Epi::MID_T) E.mid(acc, cur, wr, fr); }
            const bool last = (t == nt - 2);
            const char* a1 = cA + (size_t)(t + 1) * kstep;
            const char* a2 = last ? nA : cA + (size_t)(t + 2) * kstep; const char* b2 = last ? nB : cB + (size_t)(t + 2) * kstep;
            const char* a3 = a2 + kstep; const char* b3 = b2 + kstep;
            if (last && has_next) S.a_ready(nxt);
            if constexpr (SP2) {
            PG8_LDB(B0, 0, 0); PG8_LDB(B1, 0, 1); PG8_SCHED; PG8_LDA(At, 0, 0); PG8_STAGE(PG8_SA(1, 1), a1 + hstepA, voffA);
            PG8_WAIT_V(8); PG8_WAIT_L(0); PG8_BAR; PG8_MMA(0, 0, At, B0); PG8_MMA(0, 1, At, B1); PG8_BAR; PG8_SCHED;
            PG8_LDA(At, 0, 1); PG8_STAGE(PG8_SB(0, 0), b2, voffB); PG8_STAGE(PG8_SB(0, 1), b2 + hstepB, voffB); PG8_STAGE(PG8_SA(0, 0), a2, voffA);
            PG8_WAIT_V(8); PG8_WAIT_L(0); PG8_BAR; PG8_MMA(1, 0, At, B0); PG8_MMA(1, 1, At, B1); PG8_BAR; PG8_SCHED;
            PG8_LDB(B0, 1, 0); PG8_LDB(B1, 1, 1); PG8_SCHED; PG8_LDA(At, 1, 0); PG8_STAGE(PG8_SA(0, 1), a2 + hstepA, voffA);
            PG8_WAIT_V(8); PG8_WAIT_L(0); PG8_BAR; PG8_MMA(0, 0, At, B0); PG8_MMA(0, 1, At, B1); PG8_BAR; PG8_SCHED;
            PG8_LDA(At, 1, 1); PG8_STAGE(PG8_SB(1, 0), b3, voffB); PG8_STAGE(PG8_SB(1, 1), b3 + hstepB, voffB); PG8_STAGE(PG8_SA(1, 0), a3, voffA);
            PG8_WAIT_V(8); PG8_WAIT_L(0); PG8_BAR; PG8_MMA(1, 0, At, B0); PG8_MMA(1, 1, At, B1); PG8_BAR; PG8_SCHED;
            } else {
            PG8_LDB(B0, 0, 0); PG8_SCHED; PG8_LDA(At, 0, 0); PG8_STAGE(PG8_SA(1, 1), a1 + hstepA, voffA);
            PG8_WAIT_L(8); PG8_BAR; PG8_WAIT_L(0); PG8_MMA(0, 0, At, B0); PG8_BAR; PG8_SCHED;
            PG8_LDB(B1, 0, 1); PG8_STAGE(PG8_SB(0, 0), b2, voffB);
            PG8_BAR; PG8_WAIT_L(0); PG8_MMA(0, 1, At, B1); PG8_BAR;
            PG8_LDA(At, 0, 1); PG8_STAGE(PG8_SA(0, 0), a2, voffA);
            PG8_BAR; PG8_WAIT_L(0); PG8_MMA(1, 0, At, B0); PG8_BAR; PG8_SCHED;
            PG8_STAGE(PG8_SB(0, 1), b2 + hstepB, voffB);
            PG8_WAIT_V(6); PG8_BAR; PG8_MMA(1, 1, At, B1); PG8_BAR;
            PG8_LDB(B0, 1, 0); PG8_SCHED; PG8_LDA(At, 1, 0); PG8_STAGE(PG8_SA(0, 1), a2 + hstepA, voffA);
            PG8_WAIT_L(8); PG8_BAR; PG8_WAIT_L(0); PG8_MMA(0, 0, At, B0); PG8_BAR; PG8_SCHED;
            PG8_LDB(B1, 1, 1); PG8_STAGE(PG8_SB(1, 0), b3, voffB);
            PG8_BAR; PG8_WAIT_L(0); PG8_MMA(0, 1, At, B1); PG8_BAR;
            PG8_LDA(At, 1, 1); PG8_STAGE(PG8_SA(1, 0), a3, voffA);
            PG8_BAR; PG8_WAIT_L(0); PG8_MMA(1, 0, At, B0); PG8_BAR; PG8_SCHED;
            PG8_STAGE(PG8_SB(1, 1), b3 + hstepB, voffB);
            PG8_WAIT_V(6); PG8_BAR; PG8_MMA(1, 1, At, B1); PG8_BAR;
            }
        }
        if constexpr (ALIGN_EPI) { if (wr == 0) PG8_BAR; }
        if constexpr (!Epi::AFTER_DRAIN) { E(acc, cur, wr, wc, fr, fq); S.done(cur); }
        if (!has_next) break;
#pragma unroll
        for (int a = 0; a < 2; ++a)
#pragma unroll
            for (int b = 0; b < 2; ++b)
#pragma unroll
                for (int m = 0; m < 4; ++m)
#pragma unroll
                    for (int n = 0; n < 2; ++n) acc[a][b][m][n] = (f32x4){0.f, 0.f, 0.f, 0.f};
        cur = nxt; cA = nA; cB = nB; ++ui;
        if constexpr (ALIGN_EPI) { if (wr == 1) PG8_BAR; }
    }
    PG8_WAIT_V(0);
    if constexpr (!ALIGN_EPI) { if (wr == 0) PG8_BAR; }
    PG8_BAR;
    if constexpr (Epi::AFTER_DRAIN) { E.fused(acc, cur, wr, wc, fr, fq, lds, wid, lane); S.done(cur); }
#undef PG8_SA
#undef PG8_SB
#undef PG8_STAGE
#undef PG8_LDA
#undef PG8_LDB
#undef PG8_MMA
#undef PG8_WAIT_V
#undef PG8_WAIT_L
#undef PG8_BAR
#undef PG8_SCHED
}
}

#define LAS __attribute__((address_space(3)))
typedef unsigned short bf16;
typedef float f32x4 __attribute__((ext_vector_type(4)));
typedef float f32x2 __attribute__((ext_vector_type(2)));
typedef short bf16x8 __attribute__((ext_vector_type(8)));
typedef short bf16x4 __attribute__((ext_vector_type(4)));
typedef unsigned u32x4 __attribute__((ext_vector_type(4)));
typedef unsigned u32x2 __attribute__((ext_vector_type(2)));
using pg8::Unit;

constexpr int NWAVES = 8, NTHR = 512;
constexpr int NT = 16384, DM = 1024, FF = 2816;
constexpr float EPS = 1e-6f;
constexpr int LDS_BYTES = 147456;
constexpr size_t MiB = 1u << 20, KiB = 1024;
constexpr size_t WS_SSQ1 = 0, WS_SSQ2 = 1 * MiB, WS_SSQ3 = 2 * MiB, WS_SSQG = 3 * MiB;
constexpr size_t WS_BAR = 5 * MiB, BAR_BYTES = 32 * KiB;
constexpr size_t WS_N1M = 4 * MiB, WS_GUM = 4 * MiB + 64 * KiB, WS_H1MF = 4 * MiB + 448 * KiB, WS_PM = 4 * MiB + 512 * KiB, WS_ST0 = 4 * MiB + 640 * KiB, WS_ZM = 4 * MiB + 896 * KiB, WS_A16 = 4 * MiB + 928 * KiB;
constexpr size_t WS_WGU1 = 8 * MiB, WS_WD1 = 19 * MiB, WS_Y = 8 * MiB;
constexpr size_t WS_WMAIN = 25 * MiB, WS_H1B = 29 * MiB, WS_WKV = 61 * MiB, WS_KVT = 29 * MiB;
constexpr size_t WS_WGLU = 63 * MiB, WS_WOUT = 64 * MiB, WS_WGU2 = 66 * MiB, WS_WD2 = 77 * MiB, WS_WY = 83 * MiB, WS_WZ = 89 * MiB, WS_ROT = 93 * MiB;
constexpr size_t WS_ACT = 98 * MiB, WS_Q = 98 * MiB, WS_K = 114 * MiB, WS_G = 130 * MiB, WS_KWT = 146 * MiB, WS_VT = 162 * MiB;
constexpr size_t WS_N1 = 186 * MiB, WS_UA = 186 * MiB, WS_MIX = 186 * MiB, WS_Z = 218 * MiB, WS_SPT = 234 * MiB, WS_END = 250 * MiB;

struct Args { const float* in[26]; float* out; unsigned char* ws; int ph_lo, ph_hi; };

__device__ __forceinline__ unsigned pk2(float lo, float hi) { unsigned r; asm volatile("v_cvt_pk_bf16_f32 %0, %1, %2" : "=v"(r) : "v"(lo), "v"(hi)); return r; }
__device__ __forceinline__ u32x4 pk8(f32x4 a, f32x4 b) { u32x4 w; w.x = pk2(a[0], a[1]); w.y = pk2(a[2], a[3]); w.z = pk2(b[0], b[1]); w.w = pk2(b[2], b[3]); return w; }
__device__ __forceinline__ float bf2f(unsigned short b) { return __uint_as_float((unsigned)b << 16); }
__device__ __forceinline__ float bflo(unsigned w) { return __uint_as_float(w << 16); }
__device__ __forceinline__ float bfhi(unsigned w) { return __uint_as_float(w & 0xffff0000u); }
__device__ __forceinline__ float sigmoidf_(float x) { return __builtin_amdgcn_rcpf(1.0f + __expf(-x)); }
__device__ __forceinline__ float siluf_(float x) { return x * sigmoidf_(x); }
__device__ __forceinline__ float gelu_tanh(float y) { return y * sigmoidf_(1.5957691216057308f * (y + 0.044715f * y * y * y)); }
__device__ __forceinline__ float wave_sum(float v) {
#pragma unroll
    for (int o = 1; o < 64; o <<= 1) v += __shfl_xor(v, o);
    return v;
}
__device__ __forceinline__ float sum4(f32x4 a) { return (a[0] + a[1]) + (a[2] + a[3]); }
__device__ __forceinline__ float sumsq4(f32x4 a) { return (a[0] * a[0] + a[1] * a[1]) + (a[2] * a[2] + a[3] * a[3]); }
__device__ __forceinline__ float rstd16(const float* ssq, int row) { return 1.0f / sqrtf(ssq[row] * (1.0f / 1024.0f) + EPS); }
__device__ __forceinline__ float ms8(const float* ssq, int row) { return ssq[row] * (1.0f / 512.0f) + EPS; }
__device__ __forceinline__ void ssq_add(float* p, float v) { (void)__hip_atomic_fetch_add(p, v, __ATOMIC_RELAXED, __HIP_MEMORY_SCOPE_AGENT); }
__device__ __forceinline__ float log2gamma(int h) { return log2f(1.0f - exp2f(-5.0f - (float)h)); }
__device__ __forceinline__ f32x4 mfma16(bf16x8 a, bf16x8 b, f32x4 c) { return __builtin_amdgcn_mfma_f32_16x16x32_bf16(a, b, c, 0, 0, 0); }

enum { MAP_PLAIN = 0, MAP_GU0 = 1, MAP_GU1 = 2, MAP_ROT = 3 };
struct TJob { const float* W; int ldw, col0, ncols, k0, kcnt; bf16* dst; int ldt, map, row_off; const float* ks; int ks_off; };
__device__ __forceinline__ int map_row(int map, int row_off, int n) {
    if (map == MAP_PLAIN) return row_off + n;
    if (map == MAP_GU0) return 256 * (n >> 7) + (n & 127);
    if (map == MAP_GU1) return 256 * (n >> 7) + 128 + (n & 127);
    const int h = n >> 7, d = n & 127; return row_off + 256 * (h >> 1) + 128 * (d >> 6) + 64 * (h & 1) + (d & 63);
}
constexpr int NJOBS = 15;
__device__ __forceinline__ TJob get_job(int j, const Args& a) {
    unsigned char* ws = a.ws; TJob t;
    t.W = nullptr; t.ldw = 0; t.col0 = 0; t.ncols = 0; t.k0 = 0; t.kcnt = 0; t.dst = nullptr; t.ldt = 0; t.map = MAP_PLAIN; t.row_off = 0; t.ks = nullptr; t.ks_off = 0;
    switch (j) {
    case 0: t.W = a.in[3]; t.ldw = FF; t.ncols = FF; t.kcnt = DM; t.dst = (bf16*)(ws + WS_WGU1); t.ldt = DM; t.map = MAP_GU0; break;
    case 1: t.W = a.in[4]; t.ldw = FF; t.ncols = FF; t.kcnt = DM; t.dst = (bf16*)(ws + WS_WGU1); t.ldt = DM; t.map = MAP_GU1; break;
    case 2: t.W = a.in[5]; t.ldw = DM; t.ncols = DM; t.kcnt = FF; t.dst = (bf16*)(ws + WS_WD1); t.ldt = FF; break;
    case 3: t.W = a.in[7]; t.ldw = 2560; t.col0 = 0; t.ncols = 512; t.kcnt = DM; t.dst = (bf16*)(ws + WS_WMAIN); t.ldt = DM; t.map = MAP_ROT; t.row_off = 0; t.ks = a.in[6]; break;
    case 4: t.W = a.in[7]; t.ldw = 2560; t.col0 = 512; t.ncols = 512; t.kcnt = DM; t.dst = (bf16*)(ws + WS_WMAIN); t.ldt = DM; t.map = MAP_ROT; t.row_off = 512; t.ks = a.in[6]; break;
    case 5: t.W = a.in[7]; t.ldw = 2560; t.col0 = 1536; t.ncols = 512; t.kcnt = DM; t.dst = (bf16*)(ws + WS_WMAIN); t.ldt = DM; t.row_off = 1024; t.ks = a.in[6]; break;
    case 6: t.W = a.in[7]; t.ldw = 2560; t.col0 = 2048; t.ncols = 512; t.kcnt = DM; t.dst = (bf16*)(ws + WS_WMAIN); t.ldt = DM; t.row_off = 1536; t.ks = a.in[6]; break;
    case 7: t.W = a.in[7]; t.ldw = 2560; t.col0 = 512; t.ncols = 512; t.kcnt = DM; t.dst = (bf16*)(ws + WS_WKV); t.ldt = DM; t.map = MAP_ROT; t.row_off = 0; t.ks = a.in[6]; break;
    case 8: t.W = a.in[7]; t.ldw = 2560; t.col0 = 1024; t.ncols = 512; t.kcnt = DM; t.dst = (bf16*)(ws + WS_WKV); t.ldt = DM; t.row_off = 512; t.ks = a.in[6]; break;
    case 9: t.W = a.in[17]; t.ldw = 512; t.ncols = 512; t.kcnt = 512; t.dst = (bf16*)(ws + WS_WGLU); t.ldt = 512; break;
    case 10: t.W = a.in[20]; t.ldw = DM; t.ncols = DM; t.k0 = 0; t.kcnt = 512; t.dst = (bf16*)(ws + WS_WOUT); t.ldt = DM; break;
    case 11: t.W = a.in[20]; t.ldw = DM; t.ncols = DM; t.k0 = 512; t.kcnt = 512; t.dst = (bf16*)(ws + WS_WOUT); t.ldt = DM; t.ks = a.in[19]; t.ks_off = 512; break;
    case 12: t.W = a.in[22]; t.ldw = FF; t.ncols = FF; t.kcnt = DM; t.dst = (bf16*)(ws + WS_WGU2); t.ldt = DM; t.map = MAP_GU0; t.ks = a.in[21]; break;
    case 13: t.W = a.in[23]; t.ldw = FF; t.ncols = FF; t.kcnt = DM; t.dst = (bf16*)(ws + WS_WGU2); t.ldt = DM; t.map = MAP_GU1; t.ks = a.in[21]; break;
    default: t.W = a.in[24]; t.ldw = DM; t.ncols = DM; t.kcnt = FF; t.dst = (bf16*)(ws + WS_WD2); t.ldt = FF; break;
    }
    return t;
}
__device__ __forceinline__ void tr_item(const TJob& J, int item, LAS float* scr, int lane) {
    const int nblk = J.ncols >> 5, kb = item / nblk, nb = item - kb * nblk, k0 = J.k0 + 64 * kb, n0 = 32 * nb;
#pragma unroll
    for (int i = 0; i < 32; ++i) { const int kk = 2 * i + (lane >> 5); float v = J.W[(size_t)(k0 + kk) * J.ldw + J.col0 + n0 + (lane & 31)]; if (J.ks) v *= J.ks[k0 + kk - J.ks_off]; scr[kk * 33 + (lane & 31)] = v; }
    asm volatile("s_waitcnt lgkmcnt(0)" ::: "memory");
    const int c = lane & 7;
#pragma unroll
    for (int j = 0; j < 4; ++j) { const int n = (lane >> 3) + 8 * j; const LAS float* s = scr + (8 * c) * 33 + n;
        u32x4 o; o.x = pk2(s[0 * 33], s[1 * 33]); o.y = pk2(s[2 * 33], s[3 * 33]); o.z = pk2(s[4 * 33], s[5 * 33]); o.w = pk2(s[6 * 33], s[7 * 33]);
        *(u32x4*)(J.dst + (size_t)map_row(J.map, J.row_off, n0 + n) * J.ldt + k0 + 8 * c) = o; }
    asm volatile("s_waitcnt lgkmcnt(0)" ::: "memory");
}
__device__ __forceinline__ void rms_row_to_bf16(const float* xrow, const float* w, bf16* orow, int lane) {
    const f32x4* xr = (const f32x4*)xrow + lane; const f32x4* wr = (const f32x4*)w + lane;
    f32x4 v[4]; float s = 0.f;
#pragma unroll
    for (int j = 0; j < 4; ++j) { v[j] = xr[64 * j]; s += sumsq4(v[j]); }
    const float rstd = 1.0f / sqrtf(wave_sum(s) * (1.0f / 1024.0f) + EPS);
    u32x2* o8 = (u32x2*)orow + lane;
#pragma unroll
    for (int j = 0; j < 4; ++j) { const f32x4 g = wr[64 * j]; u32x2 o; o.x = pk2(v[j][0] * rstd * g[0], v[j][1] * rstd * g[1]); o.y = pk2(v[j][2] * rstd * g[2], v[j][3] * rstd * g[3]); o8[64 * j] = o; }
}
__device__ __forceinline__ void rms_rows2_to_bf16(const float* xa, const float* xb, const float* w, bf16* oa, bf16* ob, int lane) {
    const f32x4* pa = (const f32x4*)xa + lane; const f32x4* pb = (const f32x4*)xb + lane; const f32x4* wr = (const f32x4*)w + lane;
    f32x4 va[4], vb[4]; float sa = 0.f, sb = 0.f;
#pragma unroll
    for (int j = 0; j < 4; ++j) { va[j] = pa[64 * j]; vb[j] = pb[64 * j]; }
#pragma unroll
    for (int j = 0; j < 4; ++j) { sa += sumsq4(va[j]); sb += sumsq4(vb[j]); }
    const float ra = 1.0f / sqrtf(wave_sum(sa) * (1.0f / 1024.0f) + EPS), rb = 1.0f / sqrtf(wave_sum(sb) * (1.0f / 1024.0f) + EPS);
    u32x2* qa = (u32x2*)oa + lane; u32x2* qb = (u32x2*)ob + lane;
#pragma unroll
    for (int j = 0; j < 4; ++j) { const f32x4 g = wr[64 * j]; u32x2 o; o.x = pk2(va[j][0] * ra * g[0], va[j][1] * ra * g[1]); o.y = pk2(va[j][2] * ra * g[2], va[j][3] * ra * g[3]); qa[64 * j] = o;
        o.x = pk2(vb[j][0] * rb * g[0], vb[j][1] * rb * g[1]); o.y = pk2(vb[j][2] * rb * g[2], vb[j][3] * rb * g[3]); qb[64 * j] = o; }
}
__device__ __forceinline__ f32x2 cmul(f32x2 a, f32x2 b) { return (f32x2){a.x * b.x - a.y * b.y, a.x * b.y + a.y * b.x}; }

__device__ __forceinline__ void ssm_mats(const Args& a, int g, LAS unsigned char* lds, int tid) {
    LAS f32x2* apow = (LAS f32x2*)lds;
    LAS f32x2* bbar = apow + 17 * 64;
    LAS f32x2* Cc = bbar + 1024;
    LAS float* Km = (LAS float*)(Cc + 1024);
    LAS f32x2* cfs = (LAS f32x2*)(Km + 4096);
    unsigned char* ws = a.ws;
    for (int idx = tid; idx < 17 * 64; idx += NTHR) {
        const int j = idx >> 6, n = idx & 63; const float lre = a.in[9][g * 64 + n], lim = a.in[10][g * 64 + n], dt = expf(a.in[11][g]);
        const float mag = expf((float)j * lre * dt); float sn, cs; sincosf((float)j * (lim * dt), &sn, &cs); const f32x2 ap = (f32x2){mag * cs, mag * sn}; apow[idx] = ap;
        if (j == 16) ((f32x2*)(ws + WS_A16))[g * 64 + n] = ap;
        if (j == 1) { const float nx = ap.x - 1.0f, ny = ap.y, den = lre * lre + lim * lim; cfs[n] = (f32x2){(nx * lre + ny * lim) / den, (ny * lre - nx * lim) / den}; }
    }
    __syncthreads();
    for (int idx = tid; idx < 1024; idx += NTHR) {
        { const int n = idx >> 4, q = idx & 15; const f32x2 b = (f32x2){a.in[12][(size_t)(g * 64 + n) * 16 + q], a.in[13][(size_t)(g * 64 + n) * 16 + q]}; bbar[idx] = cmul(cfs[n], b); }
        { const int p = idx >> 6, n = idx & 63; Cc[idx] = (f32x2){a.in[14][(size_t)(g * 16 + p) * 64 + n], a.in[15][(size_t)(g * 16 + p) * 64 + n]}; }
    }
    __syncthreads();
    {
        const int j = tid >> 5, p = (tid >> 1) & 15, qh = tid & 1; float acc[8];
#pragma unroll
        for (int q = 0; q < 8; ++q) acc[q] = 0.f;
        for (int n = 0; n < 64; ++n) { const f32x2 ca = cmul(Cc[p * 64 + n], apow[j * 64 + n]);
#pragma unroll
            for (int q = 0; q < 8; ++q) { const f32x2 b = bbar[n * 16 + qh * 8 + q]; acc[q] += ca.x * b.x - ca.y * b.y; } }
#pragma unroll
        for (int q = 0; q < 8; ++q) Km[(j * 16 + p) * 16 + qh * 8 + q] = acc[q];
    }
    __syncthreads();
    bf16* WY = (bf16*)(ws + WS_WY) + (size_t)g * 256 * 384; bf16* WZ = (bf16*)(ws + WS_WZ) + (size_t)g * 256 * 256;
    for (int idx = tid; idx < 256 * 192; idx += NTHR) {
        const int r = idx / 192, c = 2 * (idx - r * 192), t = r >> 4, p = r & 15; float v0, v1;
        if (c < 256) { const int s = c >> 4, q = c & 15; if (t >= s) { v0 = Km[((t - s) * 16 + p) * 16 + q]; v1 = Km[((t - s) * 16 + p) * 16 + q + 1]; } else { v0 = 0.f; v1 = 0.f; } }
        else { const int nn = c - 256, n = nn & 63; const f32x2 c0 = cmul(Cc[p * 64 + n], apow[(t + 1) * 64 + n]), c1 = cmul(Cc[p * 64 + n + 1], apow[(t + 1) * 64 + n + 1]);
            if (nn < 64) { v0 = c0.x; v1 = c1.x; } else { v0 = -c0.y; v1 = -c1.y; } }
        *(unsigned*)(WY + (size_t)r * 384 + c) = pk2(v0, v1);
    }
    for (int idx = tid; idx < 256 * 128; idx += NTHR) {
        const int r = idx >> 7, c = 2 * (idx & 127), s = c >> 4, q = c & 15; float v0 = 0.f, v1 = 0.f;
        if (r < 128) { const int n = r & 63; const f32x2 z0 = cmul(apow[(15 - s) * 64 + n], bbar[n * 16 + q]), z1 = cmul(apow[(15 - s) * 64 + n], bbar[n * 16 + q + 1]);
            if (r < 64) { v0 = z0.x; v1 = z1.x; } else { v0 = z0.y; v1 = z1.y; } }
        *(unsigned*)(WZ + (size_t)r * 256 + c) = pk2(v0, v1);
    }
    __syncthreads();
}

template <class AL, class EP>
__device__ __forceinline__ void skinny(const bf16* Bt, int ldb, int ngroups, int nsplit, int K, int task0, int ntask_stride, const AL& al, const EP& ep, int lane) {
    const int fr = lane & 15, fq = lane >> 4, kper = K / nsplit;
    for (int t = task0; t < ngroups * nsplit; t += ntask_stride) {
        const int grp = t % ngroups, sp = t / ngroups;
        f32x4 acc = (f32x4){0.f, 0.f, 0.f, 0.f};
        const bf16* bp = Bt + (size_t)(grp * 16 + fr) * ldb + fq * 8;
#pragma unroll 4
        for (int k = sp * kper; k < (sp + 1) * kper; k += 32) { const bf16x8 b = *(const bf16x8*)(bp + k); const bf16x8 av = al(fr, k + fq * 8); acc = mfma16(b, av, acc); }
        ep(fr, grp * 16 + fq * 4, acc);
    }
}
struct ALBf16 { const bf16* A; int lda; __device__ __forceinline__ bf16x8 operator()(int r, int k) const { return *(const bf16x8*)(A + (size_t)r * lda + k); } };
struct ALF32 { const float* A; int lda; __device__ __forceinline__ bf16x8 operator()(int r, int k) const { const f32x4* p = (const f32x4*)(A + (size_t)r * lda + k); return __builtin_bit_cast(bf16x8, pk8(p[0], p[1])); } };
struct ALSwiGLU { const float* GU; __device__ __forceinline__ bf16x8 operator()(int r, int k) const {
        const float* p = GU + (size_t)r * 5632 + 256 * (k >> 7) + (k & 127); const f32x4 g0 = *(const f32x4*)p, g1 = *(const f32x4*)(p + 4), u0 = *(const f32x4*)(p + 128), u1 = *(const f32x4*)(p + 132); f32x4 a0, a1;
#pragma unroll
        for (int e = 0; e < 4; ++e) { a0[e] = siluf_(g0[e]) * u0[e]; a1[e] = siluf_(g1[e]) * u1[e]; }
        return __builtin_bit_cast(bf16x8, pk8(a0, a1)); } };
struct EPStore { float* O; int ldo; __device__ __forceinline__ void operator()(int r, int c, f32x4 v) const { *(f32x4*)(O + (size_t)r * ldo + c) = v; } };
struct EPAtomic { float* O; int ldo; float sc; __device__ __forceinline__ void operator()(int r, int c, f32x4 v) const { float* p = O + (size_t)r * ldo + c;
#pragma unroll
        for (int e = 0; e < 4; ++e) ssq_add(p + e, sc * v[e]); } };

struct P3Order {
    int G, c;
    __device__ bool next(int i, Unit& u) const { const int L = i * G + c; if (L >= 768) return false;
        if (L < 512) { u.pm = L >> 3; u.pn = L & 7; } else { const int l = L - 512; u.pn = 8 + (l >> 2); u.pm = 64 + (l & 3); } return true; }
    __device__ __forceinline__ void a_ready(const Unit&) const {}
    __device__ __forceinline__ void done(const Unit&) const {}
};
struct GroupOrder {
    int G, c;
    __device__ bool next(int i, Unit& u) const { const int L = i * G + c; if (L >= 128) return false; u.pm = L; u.pn = L >> 2; return true; }
    __device__ __forceinline__ void a_ready(const Unit&) const {}
    __device__ __forceinline__ void done(const Unit&) const {}
};

struct EpiSwiGLU {
    static constexpr bool PERM = true, AFTER_DRAIN = false, HAS_MID = false;
    bf16* O; const float* ssq;
    __device__ __forceinline__ void operator()(const f32x4 (&acc)[2][2][4][2], const Unit& u, int wr, int wc, int fr, int fq) const {
        asm volatile("" : "+v"(fr), "+v"(fq));
        const int col0 = u.pn * 128 + wc * 32 + 8 * fq;
#pragma unroll
        for (int ai = 0; ai < 2; ++ai)
#pragma unroll
            for (int m = 0; m < 4; ++m) { const int row = u.pm * 256 + ai * 128 + wr * 64 + m * 16 + fr; const float rs = ssq ? rstd16(ssq, row) : 1.0f;
                f32x4 a0, a1;
#pragma unroll
                for (int e = 0; e < 4; ++e) { a0[e] = siluf_(acc[ai][0][m][0][e] * rs) * (acc[ai][1][m][0][e] * rs); a1[e] = siluf_(acc[ai][0][m][1][e] * rs) * (acc[ai][1][m][1][e] * rs); }
                *(u32x4*)(O + (size_t)row * FF + col0) = pk8(a0, a1); asm volatile("" ::: "memory"); }
    }
};
template <int MODE>
struct EpiRes {
    static constexpr bool PERM = true, AFTER_DRAIN = false, HAS_MID = (MODE == 1); static constexpr int MID_T = 8;
    const float* base; float* out; bf16* hb; float* ssq_out; const float* ssqg;
    __device__ __forceinline__ void mid(f32x4 (&acc)[2][2][4][2], const Unit& u, int wr, int fr) const {
#pragma unroll
        for (int ai = 0; ai < 2; ++ai)
#pragma unroll
            for (int m = 0; m < 4; ++m) { const int row = u.pm * 256 + ai * 128 + wr * 64 + m * 16 + fr; const float f = sqrtf(ms8(ssqg, row));
#pragma unroll
                for (int bj = 0; bj < 2; ++bj)
#pragma unroll
                    for (int n = 0; n < 2; ++n) acc[ai][bj][m][n] = acc[ai][bj][m][n] * f; }
    }
    __device__ __forceinline__ void operator()(const f32x4 (&acc)[2][2][4][2], const Unit& u, int wr, int wc, int fr, int fq) const {
        asm volatile("" : "+v"(fr), "+v"(fq));
#pragma unroll
        for (int ai = 0; ai < 2; ++ai)
#pragma unroll
            for (int m = 0; m < 4; ++m) { const int row = u.pm * 256 + ai * 128 + wr * 64 + m * 16 + fr; const float sc = MODE == 0 ? 0.5f : 1.0f / sqrtf(ms8(ssqg, row)); float ss = 0.f;
#pragma unroll
                for (int bj = 0; bj < 2; ++bj) { const size_t off = (size_t)row * DM + u.pn * 256 + bj * 128 + wc * 32 + 8 * fq;
                    const f32x4 b0 = *(const f32x4*)(base + off), b1 = *(const f32x4*)(base + off + 4); const f32x4 h0 = b0 + sc * acc[ai][bj][m][0], h1 = b1 + sc * acc[ai][bj][m][1];
                    *(f32x4*)(out + off) = h0; *(f32x4*)(out + off + 4) = h1; if (hb) *(u32x4*)(hb + off) = pk8(h0, h1); ss += sumsq4(h0) + sumsq4(h1); }
                ss += __shfl_xor(ss, 16); ss += __shfl_xor(ss, 32);
                if (fq == 0) ssq_add(ssq_out + row, ss); asm volatile("" ::: "memory"); }
    }
};
struct EpiFinal {
    static constexpr bool PERM = true, AFTER_DRAIN = false, HAS_MID = false;
    const float* base; float* out; float* ssq; unsigned* cnt; const float* w;
    __device__ __forceinline__ void operator()(f32x4 (&acc)[2][2][4][2], const Unit& u, int wr, int wc, int fr, int fq) const {
        asm volatile("" : "+v"(fr), "+v"(fq));
#pragma unroll
        for (int ai = 0; ai < 2; ++ai)
#pragma unroll
            for (int m = 0; m < 4; ++m) { const int row = u.pm * 256 + ai * 128 + wr * 64 + m * 16 + fr; float ss = 0.f;
#pragma unroll
                for (int bj = 0; bj < 2; ++bj) { const size_t off = (size_t)row * DM + u.pn * 256 + bj * 128 + wc * 32 + 8 * fq;
                    const f32x4 b0 = *(const f32x4*)(base + off), b1 = *(const f32x4*)(base + off + 4); const f32x4 h0 = b0 + 0.5f * acc[ai][bj][m][0], h1 = b1 + 0.5f * acc[ai][bj][m][1];
                    acc[ai][bj][m][0] = h0; acc[ai][bj][m][1] = h1; ss += sumsq4(h0) + sumsq4(h1); }
                ss += __shfl_xor(ss, 16); ss += __shfl_xor(ss, 32);
                if (fq == 0) ssq_add(ssq + row, ss); asm volatile("" ::: "memory"); }
        asm volatile("s_waitcnt vmcnt(0)" ::: "memory");
        unsigned* c = cnt + 64 * u.pm;
        if (fr == 0 && fq == 0) (void)__hip_atomic_fetch_add(c, 1u, __ATOMIC_RELAXED, __HIP_MEMORY_SCOPE_AGENT);
        for (unsigned sp = 0; sp < (1u << 20); ++sp) { if ((unsigned)__builtin_amdgcn_readfirstlane(__hip_atomic_load(c, __ATOMIC_RELAXED, __HIP_MEMORY_SCOPE_AGENT)) >= 32u) break; __builtin_amdgcn_s_sleep(2); }
        asm volatile("" ::: "memory");
#pragma unroll
        for (int ai = 0; ai < 2; ++ai)
#pragma unroll
            for (int m = 0; m < 4; ++m) { const int row = u.pm * 256 + ai * 128 + wr * 64 + m * 16 + fr;
                const float rs = 1.0f / sqrtf(__hip_atomic_load(ssq + row, __ATOMIC_RELAXED, __HIP_MEMORY_SCOPE_AGENT) * (1.0f / 1024.0f) + EPS);
#pragma unroll
                for (int bj = 0; bj < 2; ++bj) { const int col = u.pn * 256 + bj * 128 + wc * 32 + 8 * fq; const size_t off = (size_t)row * DM + col;
                    const f32x4 w0 = *(const f32x4*)(w + col), w1 = *(const f32x4*)(w + col + 4);
                    *(f32x4*)(out + off) = acc[ai][bj][m][0] * rs * w0; *(f32x4*)(out + off + 4) = acc[ai][bj][m][1] * rs * w1; }
                asm volatile("" ::: "memory"); }
    }
};
struct EpiInProj {
    static constexpr bool PERM = true, AFTER_DRAIN = false, HAS_MID = false;
    const float* ssq1; const f32x2* rot; bf16 *Q, *K, *G, *UA, *KWT, *VT;
    __device__ __forceinline__ void operator()(const f32x4 (&acc)[2][2][4][2], const Unit& u, int wr, int wc, int fr, int fq) const {
        asm volatile("" : "+v"(fr), "+v"(fq));
        if (u.pm < 64) {
#ifndef NO_NORMAL
            const int pn = u.pn;
            if (pn < 4) {
                bf16* O = pn < 2 ? Q : K; const float sc = pn < 2 ? 1.0f : 0.08838834764831845f; const int p0 = wc * 32 + 8 * fq, head = 2 * (pn & 1) + (p0 >> 6), i0 = p0 & 63;
#pragma unroll
                for (int ai = 0; ai < 2; ++ai)
#pragma unroll
                    for (int m = 0; m < 4; ++m) { const int row = u.pm * 256 + ai * 128 + wr * 64 + m * 16 + fr; const float rs = rstd16(ssq1, row) * sc; const int pos = 16 + (row & 8191);
                        const f32x4* rp = (const f32x4*)(rot + (size_t)pos * 64 + i0); f32x4 o1[2], o2[2];
#pragma unroll
                        for (int n = 0; n < 2; ++n) { const f32x4 ra = rp[2 * n], rb = rp[2 * n + 1]; const f32x4 x1 = acc[ai][0][m][n], x2 = acc[ai][1][m][n];
                            o1[n][0] = (x1[0] * ra[0] - x2[0] * ra[1]) * rs; o2[n][0] = (x1[0] * ra[1] + x2[0] * ra[0]) * rs;
                            o1[n][1] = (x1[1] * ra[2] - x2[1] * ra[3]) * rs; o2[n][1] = (x1[1] * ra[3] + x2[1] * ra[2]) * rs;
                            o1[n][2] = (x1[2] * rb[0] - x2[2] * rb[1]) * rs; o2[n][2] = (x1[2] * rb[1] + x2[2] * rb[0]) * rs;
                            o1[n][3] = (x1[3] * rb[2] - x2[3] * rb[3]) * rs; o2[n][3] = (x1[3] * rb[3] + x2[3] * rb[2]) * rs; }
                        bf16* op = O + (size_t)row * 512 + head * 128 + i0; *(u32x4*)op = pk8(o1[0], o1[1]); *(u32x4*)(op + 64) = pk8(o2[0], o2[1]); asm volatile("" ::: "memory"); if (m & 1) __builtin_amdgcn_sched_barrier(0); }
            } else if (pn < 6) {
#pragma unroll
                for (int ai = 0; ai < 2; ++ai)
#pragma unroll
                    for (int m = 0; m < 4; ++m) { const int row = u.pm * 256 + ai * 128 + wr * 64 + m * 16 + fr; const float rs = rstd16(ssq1, row);
#pragma unroll
                        for (int bj = 0; bj < 2; ++bj) *(u32x4*)(G + (size_t)row * 512 + (pn - 4) * 256 + bj * 128 + wc * 32 + 8 * fq) = pk8(acc[ai][bj][m][0] * rs, acc[ai][bj][m][1] * rs); }
            } else {
#pragma unroll
                for (int ai = 0; ai < 2; ++ai)
#pragma unroll
                    for (int m = 0; m < 4; ++m) { const int row = u.pm * 256 + ai * 128 + wr * 64 + m * 16 + fr; const float rs = rstd16(ssq1, row); const int chunk = row >> 4, s = row & 15;
#pragma unroll
                        for (int bj = 0; bj < 2; ++bj) { const int ch = (pn - 6) * 256 + bj * 128 + wc * 32 + 8 * fq;
                            *(u32x4*)(UA + ((size_t)(ch >> 4) * 1024 + chunk) * 384 + s * 16 + (ch & 15)) = pk8(acc[ai][bj][m][0] * rs, acc[ai][bj][m][1] * rs); } }
            }
#endif
        } else {
#ifndef NO_SWAP
            const int tokb = (u.pn - 8) * 256 + wc * 32 + 8 * fq;
            if (u.pm < 66) {
                const int head = 2 * (u.pm - 64) + wr; const float l2g = log2gamma(head);
#pragma unroll
                for (int bj = 0; bj < 2; ++bj) { const int tok0 = tokb + bj * 128; float rs[8];
#pragma unroll
                    for (int e = 0; e < 8; ++e) rs[e] = rstd16(ssq1, tok0 + e) * 0.08838834764831845f * exp2f(l2g * (float)(127 - ((tok0 + e) & 127)));
#pragma unroll
                    for (int m = 0; m < 4; ++m) { const int i = 16 * m + fr; f32x4 o1[2], o2[2];
#pragma unroll
                        for (int e = 0; e < 8; ++e) { const int pos = 16 + ((tok0 + e) & 8191); const f32x2 cs = rot[(size_t)pos * 64 + i]; const float x1 = acc[0][bj][m][e >> 2][e & 3], x2 = acc[1][bj][m][e >> 2][e & 3];
                            o1[e >> 2][e & 3] = (x1 * cs.x - x2 * cs.y) * rs[e]; o2[e >> 2][e & 3] = (x1 * cs.y + x2 * cs.x) * rs[e]; }
                        *(u32x4*)(KWT + (size_t)(head * 128 + i) * NT + tok0) = pk8(o1[0], o1[1]); *(u32x4*)(KWT + (size_t)(head * 128 + 64 + i) * NT + tok0) = pk8(o2[0], o2[1]); asm volatile("" ::: "memory"); __builtin_amdgcn_sched_barrier(0); } }
            } else {
#pragma unroll
                for (int bj = 0; bj < 2; ++bj) { const int tok0 = tokb + bj * 128; f32x4 r0, r1;
#pragma unroll
                    for (int e = 0; e < 4; ++e) { r0[e] = rstd16(ssq1, tok0 + e); r1[e] = rstd16(ssq1, tok0 + 4 + e); }
#pragma unroll
                    for (int ai = 0; ai < 2; ++ai)
#pragma unroll
                        for (int m = 0; m < 4; ++m) { const int r = (u.pm - 66) * 256 + ai * 128 + wr * 64 + m * 16 + fr; *(u32x4*)(VT + (size_t)r * NT + tok0) = pk8(acc[ai][bj][m][0] * r0, acc[ai][bj][m][1] * r1); } }
            }
#endif
        }
    }
};
struct EpiZ {
    static constexpr bool PERM = true, AFTER_DRAIN = false, HAS_MID = false;
    float* Z;
    __device__ __forceinline__ void operator()(const f32x4 (&acc)[2][2][4][2], const Unit& u, int wr, int wc, int fr, int fq) const {
        asm volatile("" : "+v"(fr), "+v"(fq));
#pragma unroll
        for (int ai = 0; ai < 2; ++ai)
#pragma unroll
            for (int m = 0; m < 4; ++m) { const int row = u.pm * 256 + ai * 128 + wr * 64 + m * 16 + fr; float* p = Z + (size_t)row * 128 + wc * 32 + 8 * fq; *(f32x4*)p = acc[ai][0][m][0]; *(f32x4*)(p + 4) = acc[ai][0][m][1]; }
    }
};
struct EpiY {
    static constexpr bool PERM = true, AFTER_DRAIN = false, HAS_MID = false;
    const bf16* UA; const float* D; bf16* Y;
    __device__ __forceinline__ void operator()(const f32x4 (&acc)[2][2][4][2], const Unit& u, int wr, int wc, int fr, int fq) const {
        asm volatile("" : "+v"(fr), "+v"(fq));
        const int grp = u.pn, p0 = 8 * (fq & 1);
        const bf16* ub = UA + (size_t)(u.pm * 256 + wr * 64 + fr) * 384 + wc * 32 + 8 * fq;
        bf16* yb = Y + (size_t)((((u.pm & 3) * 256 + wr * 64 + fr) * 16) + wc * 2 + (fq >> 1)) * 512 + grp * 16 + p0;
        const f32x4 d0 = *(const f32x4*)(D + grp * 16 + p0), d1 = *(const f32x4*)(D + grp * 16 + p0 + 4);
#pragma unroll
        for (int ai = 0; ai < 2; ++ai)
#pragma unroll
            for (int m = 0; m < 4; ++m) {
#pragma unroll
                for (int bj = 0; bj < 2; ++bj) {
                    const u32x4 uv = *(const u32x4*)(ub + (ai * 128 + m * 16) * 384 + bj * 128);
                    f32x4 y0 = acc[ai][bj][m][0], y1 = acc[ai][bj][m][1];
                    y0[0] += d0[0] * bflo(uv.x); y0[1] += d0[1] * bfhi(uv.x); y0[2] += d0[2] * bflo(uv.y); y0[3] += d0[3] * bfhi(uv.y);
                    y1[0] += d1[0] * bflo(uv.z); y1[1] += d1[1] * bfhi(uv.z); y1[2] += d1[2] * bflo(uv.w); y1[3] += d1[3] * bfhi(uv.w);
#pragma unroll
                    for (int e = 0; e < 4; ++e) { y0[e] = gelu_tanh(y0[e]); y1[e] = gelu_tanh(y1[e]); }
                    *(u32x4*)(yb + (size_t)((ai * 128 + m * 16) * 16 + bj * 8) * 512) = pk8(y0, y1); __builtin_amdgcn_sched_barrier(0); }
                asm volatile("" ::: "memory"); }
    }
};
struct EpiGLU {
    static constexpr bool PERM = true, AFTER_DRAIN = false, HAS_MID = false;
    const bf16* Y; const float* bias; bf16* MIX; float* ssqg;
    __device__ __forceinline__ void operator()(const f32x4 (&acc)[2][2][4][2], const Unit& u, int wr, int wc, int fr, int fq) const {
        asm volatile("" : "+v"(fr), "+v"(fq));
#pragma unroll
        for (int ai = 0; ai < 2; ++ai)
#pragma unroll
            for (int m = 0; m < 4; ++m) { const int row = u.pm * 256 + ai * 128 + wr * 64 + m * 16 + fr; float ss = 0.f;
#pragma unroll
                for (int bj = 0; bj < 2; ++bj) { const int col = u.pn * 256 + bj * 128 + wc * 32 + 8 * fq;
                    const u32x4 yv = *(const u32x4*)(Y + (size_t)row * 512 + col); const f32x4 b0 = *(const f32x4*)(bias + col), b1 = *(const f32x4*)(bias + col + 4);
                    const f32x4 z0 = acc[ai][bj][m][0] + b0, z1 = acc[ai][bj][m][1] + b1; f32x4 y0, y1;
                    y0[0] = bflo(yv.x) * sigmoidf_(z0[0]); y0[1] = bfhi(yv.x) * sigmoidf_(z0[1]); y0[2] = bflo(yv.y) * sigmoidf_(z0[2]); y0[3] = bfhi(yv.y) * sigmoidf_(z0[3]);
                    y1[0] = bflo(yv.z) * sigmoidf_(z1[0]); y1[1] = bfhi(yv.z) * sigmoidf_(z1[1]); y1[2] = bflo(yv.w) * sigmoidf_(z1[2]); y1[3] = bfhi(yv.w) * sigmoidf_(z1[3]);
                    ss += sumsq4(y0) + sumsq4(y1); *(u32x4*)(MIX + (size_t)row * DM + 512 + col) = pk8(y0, y1); }
                ss += __shfl_xor(ss, 16); ss += __shfl_xor(ss, 32);
                if (fq == 0) ssq_add(ssqg + row, ss); asm volatile("" ::: "memory"); }
    }
};

#define LD16(off) (*(const bf16x8*)(ws + (off)))
#define LD8(off) (*(const u32x2*)(ws + (off)))
__device__ __forceinline__ void r1_item(int item, unsigned char* ws, int w, int lane) {
    const int bh = item >> 6, n = item & 63, b = bh >> 2, h = bh & 3, fr = lane & 15, fq = lane >> 4; const int tok0 = b * 8192 + n * 128;
    const unsigned voff = (unsigned)WS_VT + (unsigned)(((h * 128 + 16 * w + fr) * NT + tok0 + 8 * fq) * 2);
    const unsigned koff = (unsigned)WS_KWT + (unsigned)(((h * 128 + fr) * NT + tok0 + 8 * fq) * 2);
    bf16x8 vf[4];
#pragma unroll
    for (int ks = 0; ks < 4; ++ks) vf[ks] = LD16(voff + 64 * ks);
    const unsigned ooff = (unsigned)WS_KVT + (unsigned)((((bh * 64 + n) * 128 + 16 * w + 4 * fq) * 128 + fr) * 4);
#pragma unroll
    for (int dt = 0; dt < 8; ++dt) { f32x4 acc = (f32x4){0.f, 0.f, 0.f, 0.f};
#pragma unroll
        for (int ks = 0; ks < 4; ++ks) acc = mfma16(vf[ks], LD16(koff + (unsigned)(dt * 16 * NT * 2 + 64 * ks)), acc);
#pragma unroll
        for (int jj = 0; jj < 4; ++jj) *(float*)(ws + ooff + (unsigned)((jj * 128 + 16 * dt) * 4)) = acc[jj]; }
}
__device__ __forceinline__ void r3_item(int item, unsigned char* ws, const float* retw, int w, int lane) {
    const int bh = item >> 6, n = item & 63, b = bh >> 2, h = bh & 3, fr = lane & 15, fq = lane >> 4; const int tok0 = b * 8192 + n * 128, irow = tok0 + 16 * w + fr;
    const float l2g = log2gamma(h);
    const unsigned qoff = (unsigned)WS_Q + (unsigned)((irow * 512 + h * 128 + 8 * fq) * 2);
    const unsigned koff = (unsigned)WS_K + (unsigned)(((tok0 + fr) * 512 + h * 128 + 8 * fq) * 2);
    const unsigned voff = (unsigned)WS_VT + (unsigned)(((h * 128 + fr) * NT + tok0 + 4 * fq) * 2);
    const unsigned soff = (unsigned)WS_SPT + (unsigned)((((bh * 64 + n) * 128 + fr) * 128 + 8 * fq) * 2);
    const unsigned goff = (unsigned)WS_G + (unsigned)((irow * 512 + h * 128 + 4 * fq) * 2);
    const unsigned moff = (unsigned)WS_MIX + (unsigned)((irow * 1024 + h * 128 + 4 * fq) * 2);
    bf16x8 qf[4];
#pragma unroll
    for (int ks = 0; ks < 4; ++ks) qf[ks] = LD16(qoff + 64 * ks);
    f32x4 s[8];
#pragma unroll
    for (int jt = 0; jt < 8; ++jt) { s[jt] = (f32x4){0.f, 0.f, 0.f, 0.f};
        if (jt <= w) {
#pragma unroll
            for (int ks = 0; ks < 4; ++ks) s[jt] = mfma16(LD16(koff + (unsigned)(jt * 16 * 512 * 2 + 64 * ks)), qf[ks], s[jt]);
#pragma unroll
            for (int jj = 0; jj < 4; ++jj) { const int dd = 16 * (w - jt) + fr - 4 * fq - jj; s[jt][jj] = dd >= 0 ? s[jt][jj] * exp2f(l2g * (float)dd) : 0.f; } } }
    f32x4 o[8];
#pragma unroll
    for (int et = 0; et < 8; ++et) o[et] = (f32x4){0.f, 0.f, 0.f, 0.f};
#pragma unroll
    for (int kp = 0; kp < 4; ++kp) if (2 * kp <= w) { const bf16x8 sf = __builtin_bit_cast(bf16x8, pk8(s[2 * kp], s[2 * kp + 1]));
#pragma unroll
        for (int et = 0; et < 8; ++et) { const u32x2 v0 = LD8(voff + (unsigned)(et * 16 * NT * 2 + 64 * kp)), v1 = LD8(voff + (unsigned)(et * 16 * NT * 2 + 64 * kp + 32));
            const u32x4 vv = (u32x4){v0.x, v0.y, v1.x, v1.y}; o[et] = mfma16(__builtin_bit_cast(bf16x8, vv), sf, o[et]); } }
    const float wq = exp2f(l2g * (float)(16 * w + fr + 1)); float s1 = 0.f;
#pragma unroll
    for (int et = 0; et < 8; ++et) { f32x4 oc = (f32x4){0.f, 0.f, 0.f, 0.f};
#pragma unroll
        for (int ks = 0; ks < 4; ++ks) oc = mfma16(LD16(soff + (unsigned)(et * 16 * 128 * 2 + 64 * ks)), qf[ks], oc);
        o[et] = o[et] + wq * oc; s1 += sum4(o[et]); }
    s1 += __shfl_xor(s1, 16); s1 += __shfl_xor(s1, 32); const float mean = s1 * (1.0f / 128.0f); float s2 = 0.f;
#pragma unroll
    for (int et = 0; et < 8; ++et) { o[et] = o[et] - mean; s2 += sumsq4(o[et]); }
    s2 += __shfl_xor(s2, 16); s2 += __shfl_xor(s2, 32);
    const float msg = *(const float*)(ws + (unsigned)WS_SSQG + (unsigned)(irow * 4)) * (1.0f / 512.0f) + EPS;
    const float sc = (1.0f / sqrtf(s2 * (1.0f / 128.0f) + EPS)) * sqrtf(msg);
    const float* wnp = retw + h * 128 + 4 * fq;
#pragma unroll
    for (int et = 0; et < 8; ++et) { const f32x4 wn = *(const f32x4*)(wnp + 16 * et); const u32x2 gv = LD8(goff + 32 * et);
        u32x2 ov; ov.x = pk2(o[et][0] * sc * wn[0] * siluf_(bflo(gv.x)), o[et][1] * sc * wn[1] * siluf_(bfhi(gv.x))); ov.y = pk2(o[et][2] * sc * wn[2] * siluf_(bflo(gv.y)), o[et][3] * sc * wn[3] * siluf_(bfhi(gv.y)));
        *(u32x2*)(ws + moff + 32 * et) = ov; }
}
constexpr int RT_PITCH = 272, RT_TILE = 128 * RT_PITCH;
__device__ __forceinline__ void rt_load(u32x4 (&r)[4], const unsigned char* ws, unsigned goff, unsigned gpitch, int tid) {
#pragma unroll
    for (int i = 0; i < 4; ++i) { const int c = tid + 512 * i; r[i] = *(const u32x4*)(ws + goff + (unsigned)(c >> 4) * gpitch + (unsigned)(c & 15) * 16u); }
}
__device__ __forceinline__ void rt_store(const u32x4 (&r)[4], LAS unsigned char* t, int tid) {
#pragma unroll
    for (int i = 0; i < 4; ++i) { const int c = tid + 512 * i; *(LAS u32x4*)(t + (c >> 4) * RT_PITCH + (c & 15) * 16) = r[i]; }
}
#define LF16(t, row, col) (*(const LAS bf16x8*)((t) + (row) * RT_PITCH + (col) * 2))
#define LF8(t, row, col) (*(const LAS u32x2*)((t) + (row) * RT_PITCH + (col) * 2))
__device__ __forceinline__ void r1_item_lds(int item, unsigned char* ws, LAS unsigned char* lds, int w, int lane, int tid) {
    const int bh = item >> 6, n = item & 63, b = bh >> 2, h = bh & 3, fr = lane & 15, fq = lane >> 4; const int tok0 = b * 8192 + n * 128;
    LAS unsigned char* Vs = lds; LAS unsigned char* Ks = lds + RT_TILE;
    { u32x4 rv[4], rk[4];
      rt_load(rv, ws, (unsigned)WS_VT + (unsigned)((h * 128 * NT + tok0) * 2), NT * 2, tid); rt_load(rk, ws, (unsigned)WS_KWT + (unsigned)((h * 128 * NT + tok0) * 2), NT * 2, tid);
      rt_store(rv, Vs, tid); rt_store(rk, Ks, tid); }
    __syncthreads();
    bf16x8 vf[4];
#pragma unroll
    for (int ks = 0; ks < 4; ++ks) vf[ks] = LF16(Vs, 16 * w + fr, 32 * ks + 8 * fq);
    const unsigned ooff = (unsigned)WS_KVT + (unsigned)((((bh * 64 + n) * 128 + 16 * w + 4 * fq) * 128 + fr) * 4);
#pragma unroll
    for (int dt = 0; dt < 8; ++dt) { f32x4 acc = (f32x4){0.f, 0.f, 0.f, 0.f};
#pragma unroll
        for (int ks = 0; ks < 4; ++ks) acc = mfma16(vf[ks], LF16(Ks, 16 * dt + fr, 32 * ks + 8 * fq), acc);
#pragma unroll
        for (int jj = 0; jj < 4; ++jj) *(float*)(ws + ooff + (unsigned)((jj * 128 + 16 * dt) * 4)) = acc[jj]; }
    __syncthreads();
}
__device__ __forceinline__ void r3_item_lds(int item, unsigned char* ws, const float* retw, LAS unsigned char* lds, int w, int lane, int tid) {
    const int bh = item >> 6, n = item & 63, b = bh >> 2, h = bh & 3, fr = lane & 15, fq = lane >> 4; const int tok0 = b * 8192 + n * 128, irow = tok0 + 16 * w + fr;
    const float l2g = log2gamma(h);
    LAS unsigned char* Qs = lds; LAS unsigned char* Ks = lds + RT_TILE; LAS unsigned char* Vs = lds + 2 * RT_TILE; LAS unsigned char* Ss = lds + 3 * RT_TILE;
    { u32x4 rq[4], rk[4], rv[4], rs[4];
      rt_load(rq, ws, (unsigned)WS_Q + (unsigned)((tok0 * 512 + h * 128) * 2), 1024, tid); rt_load(rk, ws, (unsigned)WS_K + (unsigned)((tok0 * 512 + h * 128) * 2), 1024, tid);
      rt_load(rv, ws, (unsigned)WS_VT + (unsigned)((h * 128 * NT + tok0) * 2), NT * 2, tid); rt_load(rs, ws, (unsigned)WS_SPT + (unsigned)((bh * 64 + n) * 16384 * 2), 256, tid);
      rt_store(rq, Qs, tid); rt_store(rk, Ks, tid); rt_store(rv, Vs, tid); rt_store(rs, Ss, tid); }
    const unsigned goff = (unsigned)WS_G + (unsigned)((irow * 512 + h * 128 + 4 * fq) * 2);
    const unsigned moff = (unsigned)WS_MIX + (unsigned)((irow * 1024 + h * 128 + 4 * fq) * 2);
    u32x2 gv[8];
#pragma unroll
    for (int et = 0; et < 8; ++et) gv[et] = *(const u32x2*)(ws + goff + 32 * et);
    __syncthreads();
    bf16x8 qf[4];
#pragma unroll
    for (int ks = 0; ks < 4; ++ks) qf[ks] = LF16(Qs, 16 * w + fr, 32 * ks + 8 * fq);
    f32x4 s[8];
#pragma unroll
    for (int jt = 0; jt < 8; ++jt) { s[jt] = (f32x4){0.f, 0.f, 0.f, 0.f};
        if (jt <= w) {
#pragma unroll
            for (int ks = 0; ks < 4; ++ks) s[jt] = mfma16(LF16(Ks, 16 * jt + fr, 32 * ks + 8 * fq), qf[ks], s[jt]);
#pragma unroll
            for (int jj = 0; jj < 4; ++jj) { const int dd = 16 * (w - jt) + fr - 4 * fq - jj; s[jt][jj] = dd >= 0 ? s[jt][jj] * exp2f(l2g * (float)dd) : 0.f; } } }
    f32x4 o[8];
#pragma unroll
    for (int et = 0; et < 8; ++et) o[et] = (f32x4){0.f, 0.f, 0.f, 0.f};
#pragma unroll
    for (int kp = 0; kp < 4; ++kp) if (2 * kp <= w) { const bf16x8 sf = __builtin_bit_cast(bf16x8, pk8(s[2 * kp], s[2 * kp + 1]));
#pragma unroll
        for (int et = 0; et < 8; ++et) { const u32x2 v0 = LF8(Vs, 16 * et + fr, 32 * kp + 4 * fq), v1 = LF8(Vs, 16 * et + fr, 32 * kp + 16 + 4 * fq);
            const u32x4 vv = (u32x4){v0.x, v0.y, v1.x, v1.y}; o[et] = mfma16(__builtin_bit_cast(bf16x8, vv), sf, o[et]); } }
    const float wq = exp2f(l2g * (float)(16 * w + fr + 1)); float s1 = 0.f;
#pragma unroll
    for (int et = 0; et < 8; ++et) { f32x4 oc = (f32x4){0.f, 0.f, 0.f, 0.f};
#pragma unroll
        for (int ks = 0; ks < 4; ++ks) oc = mfma16(LF16(Ss, 16 * et + fr, 32 * ks + 8 * fq), qf[ks], oc);
        o[et] = o[et] + wq * oc; s1 += sum4(o[et]); }
    s1 += __shfl_xor(s1, 16); s1 += __shfl_xor(s1, 32); const float mean = s1 * (1.0f / 128.0f); float s2 = 0.f;
#pragma unroll
    for (int et = 0; et < 8; ++et) { o[et] = o[et] - mean; s2 += sumsq4(o[et]); }
    s2 += __shfl_xor(s2, 16); s2 += __shfl_xor(s2, 32);
    const float sc = 1.0f / sqrtf(s2 * (1.0f / 128.0f) + EPS);
    const float* wnp = retw + h * 128 + 4 * fq;
#pragma unroll
    for (int et = 0; et < 8; ++et) { const f32x4 wn = *(const f32x4*)(wnp + 16 * et);
        u32x2 ov; ov.x = pk2(o[et][0] * sc * wn[0] * siluf_(bflo(gv[et].x)), o[et][1] * sc * wn[1] * siluf_(bfhi(gv[et].x))); ov.y = pk2(o[et][2] * sc * wn[2] * siluf_(bflo(gv[et].y)), o[et][3] * sc * wn[3] * siluf_(bfhi(gv[et].y)));
        *(u32x2*)(ws + moff + 32 * et) = ov; }
    __syncthreads();
}

#define XB_TMO      128
#define XB_XCNT(j)  (256  + 64 * (j))
#define XB_XSUB(j)  (1280 + 64 * (j))
#define XB_XGEN(j)  (2304 + 64 * (j))
#define XB_TOP      3328
#define XB_TOPGEN   3392
#define XCD_BAR_WORDS 3456
#define XB_SPIN_CAP (1u << 18)

__device__ __forceinline__ unsigned xb_ld(unsigned* p)              { return __hip_atomic_load(p, __ATOMIC_RELAXED, __HIP_MEMORY_SCOPE_AGENT); }
__device__ __forceinline__ unsigned xb_add(unsigned* p, unsigned v) { return __hip_atomic_fetch_add(p, v, __ATOMIC_RELAXED, __HIP_MEMORY_SCOPE_AGENT); }
__device__ __forceinline__ unsigned xb_xcc_id() { return (unsigned)__builtin_amdgcn_s_getreg((3 << 11) | 20) & 0xFu; }
#define XB_SPIN(cond, bar) do { unsigned _sp = 0; while (cond) { __builtin_amdgcn_s_sleep(1); \
    if ((++_sp & 255u) == 0u) { if (xb_ld(&(bar)[XB_TMO])) break; if (_sp > XB_SPIN_CAP) { atomicAdd(&(bar)[XB_TMO], 1u); break; } } } } while (0)

struct XcdBarrier {
    unsigned* bar; unsigned x;
    volatile LAS unsigned* st;
};

__device__ __forceinline__ XcdBarrier xcd_barrier_post(unsigned* bar, volatile LAS unsigned* st) {
    XcdBarrier b; b.bar = bar; b.x = xb_xcc_id(); b.st = st;
    if (threadIdx.x == 0) (void)xb_add(&bar[XB_XCNT(b.x)], 1u);
    return b;
}
__device__ __forceinline__ void xcd_barrier_complete(unsigned* bar, unsigned x, unsigned& nloc, unsigned& nx) {
    const unsigned G = gridDim.x * gridDim.y * gridDim.z;
    unsigned sum, cnt, mine, sp = 0u;
    for (;;) {
        sum = 0u; cnt = 0u; mine = 0u;
#pragma unroll
        for (unsigned j = 0; j < 16; ++j) { const unsigned c = xb_ld(&bar[XB_XCNT(j)]); sum += c; cnt += (c > 0u) ? 1u : 0u; mine = (j == x) ? c : mine; }
        if (sum == G) break;
        __builtin_amdgcn_s_sleep(1);
        if ((++sp & 255u) == 0u) { if (xb_ld(&bar[XB_TMO])) break; if (sp > XB_SPIN_CAP) { atomicAdd(&bar[XB_TMO], 1u); break; } }
    }
    nloc = mine > 0u ? mine : 1u; nx = cnt > 0u ? cnt : 1u;
}

__device__ __forceinline__ void xcd_barrier(const XcdBarrier& b) {
    asm volatile("s_waitcnt vmcnt(0)" ::: "memory");
    __syncthreads();
    if (threadIdx.x == 0) {
        unsigned* bar = b.bar;
        __builtin_amdgcn_s_waitcnt(0);
        unsigned nloc = b.st[0], nx = b.st[1];
        if (nloc == 0u) { xcd_barrier_complete(bar, b.x, nloc, nx); b.st[0] = nloc; b.st[1] = nx; }
        const unsigned old = xb_add(&bar[XB_XSUB(b.x)], 1u);
        const unsigned gen = old / nloc;
        if (old + 1u == (gen + 1u) * nloc) {
            __builtin_amdgcn_fence(__ATOMIC_RELEASE, "agent");
            asm volatile("s_waitcnt vmcnt(0)" ::: "memory");
            const unsigned og = xb_add(&bar[XB_TOP], 1u);
            const unsigned tg = og / nx;
            if (og + 1u == (tg + 1u) * nx) xb_add(&bar[XB_TOPGEN], 1u);
            else XB_SPIN(xb_ld(&bar[XB_TOPGEN]) == tg, bar);
            __builtin_amdgcn_fence(__ATOMIC_ACQUIRE, "agent");
            xb_add(&bar[XB_XGEN(b.x)], 1u);
            asm volatile("s_waitcnt vmcnt(0)" ::: "memory");
        } else {
            XB_SPIN(xb_ld(&bar[XB_XGEN(b.x)]) == gen, bar);
            __builtin_amdgcn_fence(__ATOMIC_ACQUIRE, "agent");
            asm volatile("s_waitcnt vmcnt(0)" ::: "memory");
        }
    }
    __syncthreads();
}


__device__ __forceinline__ void touch_res_tile(const float* base, int G, int bx, int tid) {
    pg8::StaticOrder S; S.init(NT, DM, G, bx); Unit u; if (!S.next(0, u)) return;
    const float* p = base + (size_t)(u.pm * 256) * DM + u.pn * 256; float acc = 0.f;
#pragma unroll
    for (int i = 0; i < 4; ++i) { const int id = tid + 512 * i; acc += p[(size_t)(id >> 3) * DM + (id & 7) * 32]; }
    asm volatile("" :: "v"(acc));
}

#define GEMM_PHASE(EpiT, SchedT, g, S, E) pg8::gemm_phase<EpiT, SchedT, true, true>((PG8_LAS unsigned char*)lds, g, S, E)

__global__ void __launch_bounds__(NTHR, 2) hymba_fwd(Args args) {
    extern __shared__ __attribute__((aligned(16))) unsigned char lds_raw[];
    LAS unsigned char* lds = (LAS unsigned char*)lds_raw;
    cg::grid_group grid = cg::this_grid();
    const int tid = threadIdx.x, lane = tid & 63, wave = __builtin_amdgcn_readfirstlane(tid >> 6);
    const int G = gridDim.x, bx = blockIdx.x, vcu = (G % 8 == 0) ? (bx % 8) * (G / 8) + bx / 8 : bx;
    const int gw = vcu * NWAVES + wave, NGW = G * NWAVES, swid = wave * G + vcu;
    const int gtid = vcu * NTHR + tid, NTH = G * NTHR;
    volatile LAS unsigned* xst = (volatile LAS unsigned*)(lds + LDS_BYTES - 16);
    if (tid == 0) { xst[0] = 0u; xst[1] = 0u; }
    __syncthreads();
    XcdBarrier xbar = xcd_barrier_post((unsigned*)(args.ws + WS_BAR), xst);
    typedef const __attribute__((address_space(4))) Args* KArgP;
#define KA() ({ KArgP _k = (KArgP)__builtin_amdgcn_kernarg_segment_ptr(); asm volatile("" : "+s"(_k)); _k; })
    const int lo = args.ph_lo, hi = args.ph_hi;
#ifndef PHASE_MASK
#define PHASE_MASK 0xffff
#endif
#define IN(k) (((PHASE_MASK >> (k)) & 1) && lo <= (k) && (k) < hi)
#ifndef REP_MASK
#define REP_MASK 0
#endif
#ifndef SYNC_REP
#define SYNC_REP 1
#endif
#define NREP(k) ((((REP_MASK) >> (k)) & 1) ? 2 : 1)
#define SEAM(k) do { if (IN(k) && IN((k) + 1)) { for (int sr = 0; sr < SYNC_REP; ++sr) { if ((k) == 0) grid.sync(); else xcd_barrier(xbar); } } } while (0)
#define SSQ1 ((float*)(ws + WS_SSQ1))
#define SSQ2 ((float*)(ws + WS_SSQ2))
#define SSQ3 ((float*)(ws + WS_SSQ3))
#define SSQG ((float*)(ws + WS_SSQG))
#define N1M ((bf16*)(ws + WS_N1M))
#define GUM ((float*)(ws + WS_GUM))
#define H1MF ((float*)(ws + WS_H1MF))
#define PM ((float*)(ws + WS_PM))
#define ST0 ((float*)(ws + WS_ST0))
#define ZM ((float*)(ws + WS_ZM))
#define A16 ((const f32x2*)(ws + WS_A16))
#define H1B ((bf16*)(ws + WS_H1B))
#define WMAIN ((bf16*)(ws + WS_WMAIN))
#define WKV ((bf16*)(ws + WS_WKV))
#define ROT ((f32x2*)(ws + WS_ROT))
#define ACT ((bf16*)(ws + WS_ACT))
#define Qb ((bf16*)(ws + WS_Q))
#define Kb ((bf16*)(ws + WS_K))
#define Gb ((bf16*)(ws + WS_G))
#define KWT ((bf16*)(ws + WS_KWT))
#define VT ((bf16*)(ws + WS_VT))
#define N1 ((bf16*)(ws + WS_N1))
#define UA ((bf16*)(ws + WS_UA))
#define MIX ((bf16*)(ws + WS_MIX))
#define Zb ((float*)(ws + WS_Z))
#define SPT ((bf16*)(ws + WS_SPT))
#define KVT ((float*)(ws + WS_KVT))
#define Yb ((bf16*)(ws + WS_Y))

    if (IN(0)) for (int rep = 0; rep < NREP(0); ++rep) {
        if (rep) __syncthreads();
        Args a0; { KArgP ka = KA(); for (int i = 0; i < 26; ++i) a0.in[i] = ka->in[i]; a0.out = ka->out; a0.ws = ka->ws; a0.ph_lo = 0; a0.ph_hi = 0; } const Args& args = a0; unsigned char* ws = a0.ws;
        for (int g = vcu; g < 32; g += G) ssm_mats(args, g, lds, tid);
        LAS float* scr = (LAS float*)(lds + wave * 16384);
        if (vcu >= 32 || G <= 32) {
            const int tw0 = (G > 32) ? gw - 32 * NWAVES : gw, tnw = (G > 32) ? NGW - 32 * NWAVES : NGW;
            int it = tw0, j = 0; TJob J = get_job(0, args); int base = 0, cnt = (J.kcnt >> 6) * (J.ncols >> 5);
            while (j < 12) {
                if (it < base + cnt) { tr_item(J, it - base, scr, lane); it += tnw; }
                else { base += cnt; ++j; if (j < 12) { J = get_job(j, args); cnt = (J.kcnt >> 6) * (J.ncols >> 5); } }
            }
        }
        for (int m = gw; m < NT + 16; m += 2 * NGW) {
            const int m2 = m + NGW;
            if (m2 < NT) rms_rows2_to_bf16(args.in[0] + (size_t)m * DM, args.in[0] + (size_t)m2 * DM, args.in[2], N1 + (size_t)m * DM, N1 + (size_t)m2 * DM, lane);
            else if (m < NT) rms_row_to_bf16(args.in[0] + (size_t)m * DM, args.in[2], N1 + (size_t)m * DM, lane);
            else rms_row_to_bf16(args.in[1] + (size_t)(m - NT) * DM, args.in[2], N1M + (size_t)(m - NT) * DM, lane);
            if (m2 >= NT && m2 < NT + 16) rms_row_to_bf16(args.in[1] + (size_t)(m2 - NT) * DM, args.in[2], N1M + (size_t)(m2 - NT) * DM, lane);
        }
        for (int idx = gtid; idx < 8208 * 64; idx += NTH) { const int pos = idx >> 6, i = idx & 63;
            const double f = exp2(-(double)i * (13.287712379549449 / 64.0)); double ang = (double)pos * f; ang -= 6.283185307179586 * floor(ang * 0.15915494309189535);
            float sn, cs; sincosf((float)ang, &sn, &cs); ROT[idx] = (f32x2){cs, sn}; }
        for (int idx = gtid; idx < NT; idx += NTH) { SSQ1[idx] = 0.f; SSQ2[idx] = 0.f; SSQ3[idx] = 0.f; SSQG[idx] = 0.f; }
        for (int idx = gtid; idx < 16 * 1024; idx += NTH) H1MF[idx] = args.in[1][idx];
        for (int idx = gtid; idx < 16 * 1536; idx += NTH) PM[idx] = 0.f;
    }
    SEAM(0);
    if (IN(1)) for (int rep = 0; rep < NREP(1); ++rep) {
        if (rep) __syncthreads();
        KArgP ka = KA(); unsigned char* ws = ka->ws;
        if (bx >= G / 2) skinny((const bf16*)(ws + WS_WGU1), DM, 352, 1, DM, wave * (G - G / 2) + (bx - G / 2), NWAVES * (G - G / 2), ALBf16{N1M, DM}, EPStore{GUM, 5632}, lane);
        pg8::Gemm g{N1, (const bf16*)(ws + WS_WGU1), DM, DM, DM}; pg8::StaticOrder S; S.init(NT, 5632, G, bx);
        EpiSwiGLU E{ACT, nullptr};
        GEMM_PHASE(EpiSwiGLU, pg8::StaticOrder, g, S, E);
        if (rep == 0) touch_res_tile(ka->in[0], G, bx, tid);
    }
    SEAM(1);
    if (IN(2)) for (int rep = 0; rep < NREP(2); ++rep) {
        if (rep) __syncthreads();
        KArgP ka = KA(); unsigned char* ws = ka->ws;
        skinny((const bf16*)(ws + WS_WD1), FF, 64, 8, FF, swid, NGW, ALSwiGLU{GUM}, EPAtomic{H1MF, 1024, 0.5f}, lane);
        pg8::Gemm g{ACT, (const bf16*)(ws + WS_WD1), FF, FF, FF}; pg8::StaticOrder S; S.init(NT, DM, G, bx);
        EpiRes<0> E{ka->in[0], ka->out, H1B, SSQ1, nullptr};
        GEMM_PHASE(EpiRes<0>, pg8::StaticOrder, g, S, E);
    }
    SEAM(2);
    if (IN(3)) for (int rep = 0; rep < NREP(3); ++rep) {
        if (rep) __syncthreads();
        KArgP ka = KA(); unsigned char* ws = ka->ws;
        skinny(WMAIN + (size_t)512 * DM, DM, 32, 4, DM, swid, NGW, ALF32{H1MF, DM}, EPAtomic{PM, 1536, 1.0f}, lane);
        skinny(WKV + (size_t)512 * DM, DM, 32, 4, DM, (swid + NGW - 128) % NGW, NGW, ALF32{H1MF, DM}, EPAtomic{PM + 512, 1536, 1.0f}, lane);
        skinny(WMAIN + (size_t)1536 * DM, DM, 32, 4, DM, (swid + NGW - 256) % NGW, NGW, ALF32{H1MF, DM}, EPAtomic{PM + 1024, 1536, 1.0f}, lane);
        pg8::Gemm g{H1B, WMAIN, DM, DM, DM}; P3Order S{G, vcu};
        EpiInProj E{SSQ1, ROT, Qb, Kb, Gb, UA, KWT, VT};
        GEMM_PHASE(EpiInProj, P3Order, g, S, E);
    }
    SEAM(3);
    if (IN(4)) for (int rep = 0; rep < NREP(4); ++rep) {
        if (rep) __syncthreads();
        KArgP ka = KA(); unsigned char* ws = ka->ws;
        const int nhalf = G / 2;
        if (vcu >= nhalf) {
            LAS float* rs1 = (LAS float*)lds;
            for (int r = wave * 2; r < wave * 2 + 2; ++r) { float s = 0.f; for (int c = lane; c < DM; c += 64) { const float v = H1MF[r * DM + c]; s += v * v; } s = wave_sum(s); if (lane == 0) rs1[r] = 1.0f / sqrtf(s * (1.0f / 1024.0f) + EPS); }
            __syncthreads();
            const int sb = vcu - nhalf, nsb = G - nhalf;
            for (int o = sb * NTHR + tid; o < 65536; o += nsb * NTHR) { const int h = o >> 14, e = (o >> 7) & 127, d = o & 127, i = d & 63; const float l2g = log2gamma(h); float acc = 0.f;
                for (int j = 0; j < 16; ++j) { const float r = rs1[j]; const float x1 = PM[j * 1536 + 256 * (h >> 1) + 64 * (h & 1) + i], x2 = PM[j * 1536 + 256 * (h >> 1) + 64 * (h & 1) + i + 128]; const f32x2 cs = ROT[j * 64 + i];
                    const float kd = (d < 64) ? (x1 * cs.x - x2 * cs.y) : (x1 * cs.y + x2 * cs.x); acc += exp2f(l2g * (float)(15 - j)) * kd * PM[j * 1536 + 512 + h * 128 + e] * (r * r * 0.08838834764831845f); }
                ST0[o] = acc; }
            for (int o = sb * NTHR + tid; o < 4096; o += nsb * NTHR) { const int g = o >> 7, r = o & 127; const bf16* wz = (const bf16*)(ws + WS_WZ) + (size_t)(g * 256 + r) * 256; float acc = 0.f;
                for (int c = 0; c < 256; ++c) acc += bf2f(wz[c]) * PM[(c >> 4) * 1536 + 1024 + g * 16 + (c & 15)] * rs1[c >> 4];
                ZM[o] = acc; }
            __syncthreads();
        }
        if (G == 256) { if (vcu >= 128) { for (int k2 = 0; k2 < 3; ++k2) r1_item_lds((vcu - 128) + 128 * k2, ws, lds, wave, lane, tid); } else r1_item_lds(384 + vcu, ws, lds, wave, lane, tid); }
        else for (int it = vcu; it < 512; it += G) r1_item_lds(it, ws, lds, wave, lane, tid);
        __syncthreads();
        int kdyn = 256; asm volatile("" : "+s"(kdyn)); pg8::Gemm g{UA, (const bf16*)(ws + WS_WZ), kdyn, 384, 256}; GroupOrder S{G, vcu};
        EpiZ E{Zb};
        GEMM_PHASE(EpiZ, GroupOrder, g, S, E);
    }
    SEAM(4);
    if (IN(6)) for (int rep = 0; rep < NREP(6); ++rep) {
        if (rep) __syncthreads();
        KArgP ka = KA(); unsigned char* ws = ka->ws;
        if (rep == 0) {
        for (int L = vcu; L < 128; L += G) {
            const int g = L >> 2, rt = L & 3, b = rt >> 1, half = rt & 1, n = lane; const f32x2 a16 = A16[g * 64 + n];
            LAS f32x2* T = (LAS f32x2*)lds;
            const float* zb = Zb + ((size_t)g * 1024 + b * 512) * 128 + n;
            for (int sg = wave; sg < 8 + 8 * half; sg += 8) { f32x2 X = (f32x2){0.f, 0.f};
                for (int c0 = 0; c0 < 32; c0 += 16) { float zr[16], zi[16];
#pragma unroll
                    for (int c = 0; c < 16; ++c) { zr[c] = zb[(size_t)(sg * 32 + c0 + c) * 128]; zi[c] = zb[(size_t)(sg * 32 + c0 + c) * 128 + 64]; }
#pragma unroll
                    for (int c = 0; c < 16; ++c) { const f32x2 t = cmul(a16, X); X = (f32x2){t.x + zr[c], t.y + zi[c]}; } }
                T[sg * 64 + n] = X; }
            __syncthreads();
            f32x2 a512 = a16;
#pragma unroll
            for (int q = 0; q < 5; ++q) a512 = cmul(a512, a512);
            { const int sg = half * 8 + wave; f32x2 X = (f32x2){ZM[g * 128 + n], ZM[g * 128 + 64 + n]};
                for (int s2 = 0; s2 < sg; ++s2) { const f32x2 t = cmul(a512, X), tt = T[s2 * 64 + n]; X = (f32x2){t.x + tt.x, t.y + tt.y}; }
                bf16* xo = UA + ((size_t)g * 1024 + b * 512 + sg * 32) * 384 + 256 + n;
                for (int c0 = 0; c0 < 32; c0 += 16) { float zr[16], zi[16];
#pragma unroll
                    for (int c = 0; c < 16; ++c) { zr[c] = zb[(size_t)(sg * 32 + c0 + c) * 128]; zi[c] = zb[(size_t)(sg * 32 + c0 + c) * 128 + 64]; }
#pragma unroll
                    for (int c = 0; c < 16; ++c) { xo[(size_t)(c0 + c) * 384] = (bf16)(pk2(X.x, 0.f) & 0xffffu); xo[(size_t)(c0 + c) * 384 + 64] = (bf16)(pk2(X.y, 0.f) & 0xffffu);
                        const f32x2 t = cmul(a16, X); X = (f32x2){t.x + zr[c], t.y + zi[c]}; } } }
            asm volatile("s_waitcnt vmcnt(0)" ::: "memory");
            __syncthreads();
        }
        {
            const bool all = (G <= 128); const int t0 = all ? gtid : gtid - 128 * NTHR, tn = all ? NTH : NTH - 128 * NTHR;
            if (all || vcu >= 128)
            for (int idx = t0; idx < 8 * 16384; idx += tn) { const int bh = idx >> 14, ed = idx & 16383, h = bh & 3; const float gch = exp2f(128.0f * log2gamma(h)); float S = ST0[h * 16384 + ed];
                const float* kv = KVT + (size_t)bh * 64 * 16384 + ed; bf16* sp = SPT + (size_t)bh * 64 * 16384 + ed;
                for (int n0 = 0; n0 < 64; n0 += 16) { float v[16];
#pragma unroll
                    for (int c = 0; c < 16; ++c) v[c] = kv[(size_t)(n0 + c) * 16384];
#pragma unroll
                    for (int c = 0; c < 16; ++c) { sp[(size_t)(n0 + c) * 16384] = (bf16)(pk2(S, 0.f) & 0xffffu); S = gch * S + v[c]; } } }
        }
        }
        if ((vcu >= 128 || G <= 128) && rep == 0) {
            Args a0; { for (int i = 0; i < 26; ++i) a0.in[i] = ka->in[i]; a0.out = nullptr; a0.ws = ws; a0.ph_lo = 0; a0.ph_hi = 0; }
            LAS float* scr = (LAS float*)(lds + wave * 16384); const int tw0 = (G <= 128) ? gw : gw - 128 * NWAVES, tnw = (G <= 128) ? NGW : NGW - 128 * NWAVES;
            int it = tw0, j = 12; TJob J = get_job(12, a0); int base = 0, cnt = (J.kcnt >> 6) * (J.ncols >> 5);
            while (j < NJOBS) {
                if (it < base + cnt) { tr_item(J, it - base, scr, lane); it += tnw; }
                else { base += cnt; ++j; if (j < NJOBS) { J = get_job(j, a0); cnt = (J.kcnt >> 6) * (J.ncols >> 5); } }
            }
        }
        int kdyn = 384; asm volatile("" : "+s"(kdyn)); pg8::Gemm g{UA, (const bf16*)(ws + WS_WY), kdyn, 384, 384}; GroupOrder S{G, vcu};
        EpiY E{UA, ka->in[16], Yb};
        GEMM_PHASE(EpiY, GroupOrder, g, S, E);
    }
    SEAM(6);
    if (IN(7)) for (int rep = 0; rep < NREP(7); ++rep) {
        if (rep) __syncthreads();
        KArgP ka = KA(); unsigned char* ws = ka->ws;
        if (rep == 0) {
            if (G == 256) { if (bx >= 128) { for (int k2 = 0; k2 < 3; ++k2) r3_item_lds((bx - 128) + 128 * k2, ws, ka->in[8], lds, wave, lane, tid); } else r3_item_lds(384 + bx, ws, ka->in[8], lds, wave, lane, tid); }
            else for (int it = vcu; it < 512; it += G) r3_item_lds(it, ws, ka->in[8], lds, wave, lane, tid);
        }
        pg8::Gemm g{Yb, (const bf16*)(ws + WS_WGLU), 512, 512, 512}; pg8::StaticOrder S; S.init(NT, 512, G, bx);
        EpiGLU E{Yb, ka->in[18], MIX, SSQG};
        GEMM_PHASE(EpiGLU, pg8::StaticOrder, g, S, E);
        if (rep == 0) touch_res_tile(ka->out, G, bx, tid);
    }
    SEAM(8);
    if (IN(9)) for (int rep = 0; rep < NREP(9); ++rep) {
        if (rep) __syncthreads();
        KArgP ka = KA(); unsigned char* ws = ka->ws; float* outp = ka->out;
        pg8::Gemm g{MIX, (const bf16*)(ws + WS_WOUT), DM, DM, DM}; pg8::StaticOrder S; S.init(NT, DM, G, bx);
        EpiRes<1> E{outp, outp, H1B, SSQ2, SSQG};
        GEMM_PHASE(EpiRes<1>, pg8::StaticOrder, g, S, E);
    }
    SEAM(9);
    if (IN(10)) for (int rep = 0; rep < NREP(10); ++rep) {
        if (rep) __syncthreads();
        KArgP ka = KA(); unsigned char* ws = ka->ws;
        pg8::Gemm g{H1B, (const bf16*)(ws + WS_WGU2), DM, DM, DM}; pg8::StaticOrder S; S.init(NT, 5632, G, bx);
        EpiSwiGLU E{ACT, SSQ2};
        GEMM_PHASE(EpiSwiGLU, pg8::StaticOrder, g, S, E);
        if (rep == 0) touch_res_tile(ka->out, G, bx, tid);
    }
    SEAM(10);
    if (IN(11)) for (int rep = 0; rep < NREP(11); ++rep) {
        if (rep) __syncthreads();
        KArgP ka = KA(); unsigned char* ws = ka->ws; float* outp = ka->out;
        pg8::Gemm g{ACT, (const bf16*)(ws + WS_WD2), FF, FF, FF}; pg8::StaticOrder S; S.init(NT, DM, G, bx);
        EpiFinal E{outp, outp, SSQ3, (unsigned*)(ws + WS_BAR + 16 * KiB), ka->in[25]};
        GEMM_PHASE(EpiFinal, pg8::StaticOrder, g, S, E);
    }
#undef IN
#undef SEAM
}

#ifndef MK_PER_PHASE
#define MK_PER_PHASE 0
#endif
constexpr int NPHASES = 13;
extern "C" void kernel_launch(void* const* d_in, const int* in_sizes, int n_in, void* d_out, int out_size, void* d_ws, size_t ws_size, hipStream_t stream) {
    static int grid = 0;
    if (grid == 0) {
        if (n_in != 26 || out_size != NT * DM || ws_size < WS_END) { fprintf(stderr, "kernel_launch: unexpected shapes (n_in %d, out %d, ws %zu)\n", n_in, out_size, ws_size); grid = -1; return; }
        int dev = 0, cus = 0, per_cu = 0;
        hipGetDevice(&dev); hipDeviceGetAttribute(&cus, hipDeviceAttributeMultiprocessorCount, dev);
        if (hipFuncSetAttribute((const void*)hymba_fwd, hipFuncAttributeMaxDynamicSharedMemorySize, LDS_BYTES) != hipSuccess) { fprintf(stderr, "kernel_launch: hipFuncSetAttribute failed\n"); grid = -1; return; }
        if (hipOccupancyMaxActiveBlocksPerMultiprocessor(&per_cu, (const void*)hymba_fwd, NTHR, LDS_BYTES) != hipSuccess || per_cu < 1) { fprintf(stderr, "kernel_launch: occupancy query failed (%d)\n", per_cu); (void)hipGetLastError(); per_cu = 1; }
        grid = cus * 1;
        fprintf(stderr, "kernel_launch: grid %d (per_cu %d), ws %zu\n", grid, per_cu, ws_size);
    }
    if (grid < 0) return;
    Args a{};
    for (int i = 0; i < 26; ++i) a.in[i] = (const float*)d_in[i];
    a.out = (float*)d_out; a.ws = (unsigned char*)d_ws;
    if (hipMemsetAsync((char*)d_ws + WS_BAR, 0, BAR_BYTES, stream) != hipSuccess) { fprintf(stderr, "kernel_launch: memset of barrier words failed\n"); return; }
#if MK_PER_PHASE
    for (int p = 0; p < NPHASES; ++p) { a.ph_lo = p; a.ph_hi = p + 1; hipLaunchKernelGGL(hymba_fwd, dim3(grid), dim3(NTHR), LDS_BYTES, stream, a); }
#else
    a.ph_lo = 0; a.ph_hi = NPHASES;
    void* kargs[] = {&a};
    hipError_t e = hipLaunchCooperativeKernel((const void*)hymba_fwd, dim3(grid), dim3(NTHR), kargs, LDS_BYTES, stream);
    if (e != hipSuccess) fprintf(stderr, "kernel_launch: cooperative launch failed: %s (grid %d)\n", hipGetErrorString(e), grid);
#endif
}
```

```cpp
#include <hip/hip_runtime.h>
#include <hip/hip_cooperative_groups.h>
#include <cstdio>
#include <cstdint>
namespace cg = cooperative_groups;
namespace pg8 {
#define PG8_LAS __attribute__((address_space(3)))
typedef unsigned short bf16_t;
typedef short bf16x8 __attribute__((ext_vector_type(8)));
typedef float f32x4 __attribute__((ext_vector_type(4)));
typedef unsigned u32x4 __attribute__((ext_vector_type(4)));
constexpr int BM = 256, BK = 64, HALF = 128, HTB = HALF * BK * 2  , STAGE_BYTES = 8 * HTB, NXCD = 8, WGM = 8;

__host__ __device__ __forceinline__ int lds_byte(int r, int c) { const int st = (r >> 4) * 2 + (c >> 5), rr = r & 15, cc = c & 31, ob = rr * 64 + cc * 2; return st * 1024 + (ob ^ (((ob >> 9) & 1) << 5)); }
__host__ __device__ __forceinline__ void stage_rc(int b, int& R, int& C) { const int st = b / 1024, sb = b % 1024, swz = sb ^ (((sb >> 9) & 1) << 5); R = (st >> 1) * 16 + swz / 64; C = (st & 1) * 32 + (swz % 64) / 2; }
__host__ __device__ __forceinline__ int perm32(int rho) { const int n = rho >> 4, i = rho & 15; return 8 * (i >> 2) + 4 * n + (i & 3); }

struct Unit { int pm, pn; };
struct Gemm { const bf16_t* A; const bf16_t* Bt; int K, lda, ldb; };

struct StaticOrder {
    int nM, nN, nwg, G, c;
    __host__ __device__ void init(int M, int N, int G_, int c_) { nM = M / BM; nN = N / BM; nwg = nM * nN; G = G_; c = c_; }
    __host__ __device__ bool next(int i, Unit& u) const {
        const long L = (long)i * G + c; if (L >= nwg) return false;
        int wgid = (int)L; { const int q = nwg / NXCD, r = nwg % NXCD, xcd = wgid % NXCD, off = wgid / NXCD; wgid = (xcd < r ? xcd * (q + 1) : r * (q + 1) + (xcd - r) * q) + off; }
        const int nig = WGM * nN, gid = wgid / nig, fm = gid * WGM, gsz = (nM - fm) < WGM ? (nM - fm) : WGM;
        u.pm = fm + ((wgid % nig) % gsz); u.pn = (wgid % nig) / gsz; return true;
    }
    __device__ __forceinline__ void a_ready(const Unit&) const {}
    __device__ __forceinline__ void done(const Unit&) const {}
};

__device__ __forceinline__ unsigned cvt_pk_bf16(float lo, float hi) { unsigned r; asm volatile("v_cvt_pk_bf16_f32 %0, %1, %2" : "=v"(r) : "v"(lo), "v"(hi)); return r; }
template <class Epi, class Sched, bool ALIGN_EPI = false, bool SP2 = false>
__device__ __forceinline__ void gemm_phase(PG8_LAS unsigned char* lds, const Gemm g, const Sched& S, const Epi& E) {
    const int tid = threadIdx.x, wid = __builtin_amdgcn_readfirstlane(tid >> 6), lane = tid & 63, wr = wid >> 2, wc = wid & 3, fr = lane & 15, fq = lane >> 4;
    const int K = g.K, nt = K / BK;
    unsigned voffA[2], voffB[2];
#pragma unroll
    for (int i = 0; i < 2; ++i) { int R, C; stage_rc(tid * 16 + i * 8192, R, C); const int Rb = Epi::PERM ? ((R & ~31) + perm32(R & 31)) : R;
        voffA[i] = (unsigned)(R * g.lda + C) * 2u; voffB[i] = (unsigned)(Rb * g.ldb + C) * 2u; }
    const size_t kstep = (size_t)(BK * 2);
    const size_t hstepA = (size_t)HALF * g.lda * 2, hstepB = (size_t)HALF * g.ldb * 2;
    const size_t tstepA = 2 * hstepA, tstepB = 2 * hstepB;
    const unsigned ldsw = (unsigned)wid * 1024u;
    const int aoff = lds_byte(wr * 64 + fr, fq * 8), boff = lds_byte(wc * 32 + fr, fq * 8);
#define PG8_SA(b, h) (((b) * 2 + (h)) * HTB)
#define PG8_SB(b, h) ((4 + (b) * 2 + (h)) * HTB)
#define PG8_STAGE(bufoff, gbase, voff) do { _Pragma("unroll") for (int _i = 0; _i < 2; ++_i) \
        __builtin_amdgcn_global_load_lds((const unsigned*)((const char*)(gbase) + (voff)[_i]), (PG8_LAS unsigned*)(lds + (bufoff) + ldsw + _i * 8192), 16, 0, 0); } while (0)
#define PG8_LDA(dst, b, h) do { _Pragma("unroll") for (int m = 0; m < 4; ++m) _Pragma("unroll") for (int k = 0; k < 2; ++k) dst[m][k] = *(const PG8_LAS bf16x8*)(lds + PG8_SA(b, h) + aoff + m * 2048 + k * 1024); } while (0)
#define PG8_LDB(dst, b, h) do { _Pragma("unroll") for (int n = 0; n < 2; ++n) _Pragma("unroll") for (int k = 0; k < 2; ++k) dst[n][k] = *(const PG8_LAS bf16x8*)(lds + PG8_SB(b, h) + boff + n * 2048 + k * 1024); } while (0)
#define PG8_MMA(ai, bj, At, Bt) do { __builtin_amdgcn_s_setprio(1); _Pragma("unroll") for (int m = 0; m < 4; ++m) _Pragma("unroll") for (int n = 0; n < 2; ++n) _Pragma("unroll") for (int k = 0; k < 2; ++k) \
        acc[ai][bj][m][n] = __builtin_amdgcn_mfma_f32_16x16x32_bf16(Bt[n][k], At[m][k], acc[ai][bj][m][n], 0, 0, 0); __builtin_amdgcn_s_setprio(0); } while (0)
#define PG8_WAIT_V(n) asm volatile("s_waitcnt vmcnt(" #n ")" ::: "memory")
#define PG8_WAIT_L(n) asm volatile("s_waitcnt lgkmcnt(" #n ")" ::: "memory")
#define PG8_BAR __builtin_amdgcn_s_barrier()
#define PG8_SCHED __builtin_amdgcn_sched_barrier(0)
    Unit cur, nxt; int ui = 0;
    if (!S.next(0, cur)) return;
    f32x4 acc[2][2][4][2];
#pragma unroll
    for (int a = 0; a < 2; ++a)
#pragma unroll
        for (int b = 0; b < 2; ++b)
#pragma unroll
            for (int m = 0; m < 4; ++m)
#pragma unroll
                for (int n = 0; n < 2; ++n) acc[a][b][m][n] = (f32x4){0.f, 0.f, 0.f, 0.f};
    bf16x8 At[4][2], B0[2][2], B1[2][2];
    const char* cA = (const char*)g.A + (size_t)cur.pm * tstepA; const char* cB = (const char*)g.Bt + (size_t)cur.pn * tstepB;
    S.a_ready(cur);
    if constexpr (SP2) {
        PG8_STAGE(PG8_SB(0, 0), cB, voffB); PG8_STAGE(PG8_SB(0, 1), cB + hstepB, voffB); PG8_STAGE(PG8_SA(0, 0), cA, voffA); PG8_STAGE(PG8_SA(0, 1), cA + hstepA, voffA);
        if (wr == 1) PG8_BAR;
        PG8_WAIT_V(2); PG8_BAR;
        PG8_STAGE(PG8_SB(1, 0), cB + kstep, voffB); PG8_STAGE(PG8_SA(1, 0), cA + kstep, voffA); PG8_STAGE(PG8_SB(1, 1), cB + hstepB + kstep, voffB);
        PG8_WAIT_V(6); PG8_BAR;
    } else {
        PG8_STAGE(PG8_SB(0, 0), cB, voffB); PG8_STAGE(PG8_SA(0, 0), cA, voffA); PG8_STAGE(PG8_SB(0, 1), cB + hstepB, voffB); PG8_STAGE(PG8_SA(0, 1), cA + hstepA, voffA);
        if (wr == 1) PG8_BAR;
        PG8_WAIT_V(4); PG8_BAR;
        PG8_STAGE(PG8_SB(1, 0), cB + kstep, voffB); PG8_STAGE(PG8_SA(1, 0), cA + kstep, voffA); PG8_STAGE(PG8_SB(1, 1), cB + hstepB + kstep, voffB);
        PG8_WAIT_V(6); PG8_BAR;
    }
    for (;;) {
        const bool has_next = S.next(ui + 1, nxt);
        const char* nA = has_next ? (const char*)g.A + (size_t)nxt.pm * tstepA : cA; const char* nB = has_next ? (const char*)g.Bt + (size_t)nxt.pn * tstepB : cB;
        for (int t = 0; t < nt; t += 2) {
            if constexpr (Epi::HAS_MID) { if (t == Epi::MID_T) E.mid(acc, cur, wr, fr); }
            const bool last = (t == nt - 2);
            const char* a1 = cA + (size_t)(t + 1) * kstep;
            const char* a2 = last ? nA : cA + (size_t)(t + 2) * kstep; const char* b2 = last ? nB : cB + (size_t)(t + 2) * kstep;
            const char* a3 = a2 + kstep; const char* b3 = b2 + kstep;
            if (last && has_next) S.a_ready(nxt);
            if constexpr (SP2) {
            PG8_LDB(B0, 0, 0); PG8_LDB(B1, 0, 1); PG8_SCHED; PG8_LDA(At, 0, 0); PG8_STAGE(PG8_SA(1, 1), a1 + hstepA, voffA);
            PG8_WAIT_V(8); PG8_WAIT_L(0); PG8_BAR; PG8_MMA(0, 0, At, B0); PG8_MMA(0, 1, At, B1); PG8_BAR; PG8_SCHED;
            PG8_LDA(At, 0, 1); PG8_STAGE(PG8_SB(0, 0), b2, voffB); PG8_STAGE(PG8_SB(0, 1), b2 + hstepB, voffB); PG8_STAGE(PG8_SA(0, 0), a2, voffA);
            PG8_WAIT_V(8); PG8_WAIT_L(0); PG8_BAR; PG8_MMA(1, 0, At, B0); PG8_MMA(1, 1, At, B1); PG8_BAR; PG8_SCHED;
            PG8_LDB(B0, 1, 0); PG8_LDB(B1, 1, 1); PG8_SCHED; PG8_LDA(At, 1, 0); PG8_STAGE(PG8_SA(0, 1), a2 + hstepA, voffA);
            PG8_WAIT_V(8); PG8_WAIT_L(0); PG8_BAR; PG8_MMA(0, 0, At, B0); PG8_MMA(0, 1, At, B1); PG8_BAR; PG8_SCHED;
            PG8_LDA(At, 1, 1); PG8_STAGE(PG8_SB(1, 0), b3, voffB); PG8_STAGE(PG8_SB(1, 1), b3 + hstepB, voffB); PG8_STAGE(PG8_SA(1, 0), a3, voffA);
            PG8_WAIT_V(8); PG8_WAIT_L(0); PG8_BAR; PG8_MMA(1, 0, At, B0); PG8_MMA(1, 1, At, B1); PG8_BAR; PG8_SCHED;
            } else {
            PG8_LDB(B0, 0, 0); PG8_SCHED; PG8_LDA(At, 0, 0); PG8_STAGE(PG8_SA(1, 1), a1 + hstepA, voffA);
            PG8_WAIT_L(8); PG8_BAR; PG8_WAIT_L(0); PG8_MMA(0, 0, At, B0); PG8_BAR; PG8_SCHED;
            PG8_LDB(B1, 0, 1); PG8_STAGE(PG8_SB(0, 0), b2, voffB);
            PG8_BAR; PG8_WAIT_L(0); PG8_MMA(0, 1, At, B1); PG8_BAR;
            PG8_LDA(At, 0, 1); PG8_STAGE(PG8_SA(0, 0), a2, voffA);
            PG8_BAR; PG8_WAIT_L(0); PG8_MMA(1, 0, At, B0); PG8_BAR; PG8_SCHED;
            PG8_STAGE(PG8_SB(0, 1), b2 + hstepB, voffB);
            PG8_WAIT_V(6); PG8_BAR; PG8_MMA(1, 1, At, B1); PG8_BAR;
            PG8_LDB(B0, 1, 0); PG8_SCHED; PG8_LDA(At, 1, 0); PG8_STAGE(PG8_SA(0, 1), a2 + hstepA, voffA);
            PG8_WAIT_L(8); PG8_BAR; PG8_WAIT_L(0); PG8_MMA(0, 0, At, B0); PG8_BAR; PG8_SCHED;
            PG8_LDB(B1, 1, 1); PG8_STAGE(PG8_SB(1, 0), b3, voffB);
            PG8_BAR; PG8_WAIT_L(0); PG8_MMA(0, 1, At, B1); PG8_BAR;
            PG8_LDA(At, 1, 1); PG8_STAGE(PG8_SA(1, 0), a3, voffA);
            PG8_BAR; PG8_WAIT_L(0); PG8_MMA(1, 0, At, B0); PG8_BAR; PG8_SCHED;
            PG8_STAGE(PG8_SB(1, 1), b3 + hstepB, voffB);
            PG8_WAIT_V(6); PG8_BAR; PG8_MMA(1, 1, At, B1); PG8_BAR;
            }
        }
        if constexpr (ALIGN_EPI) { if (wr == 0) PG8_BAR; }
        if constexpr (!Epi::AFTER_DRAIN) { E(acc, cur, wr, wc, fr, fq); S.done(cur); }
        if (!has_next) break;
#pragma unroll
        for (int a = 0; a < 2; ++a)
#pragma unroll
            for (int b = 0; b < 2; ++b)
#pragma unroll
                for (int m = 0; m < 4; ++m)
#pragma unroll
                    for (int n = 0; n < 2; ++n) acc[a][b][m][n] = (f32x4){0.f, 0.f, 0.f, 0.f};
        cur = nxt; cA = nA; cB = nB; ++ui;
        if constexpr (ALIGN_EPI) { if (wr == 1) PG8_BAR; }
    }
    PG8_WAIT_V(0);
    if constexpr (!ALIGN_EPI) { if (wr == 0) PG8_BAR; }
    PG8_BAR;
    if constexpr (Epi::AFTER_DRAIN) { E.fused(acc, cur, wr, wc, fr, fq, lds, wid, lane); S.done(cur); }
#undef PG8_SA
#undef PG8_SB
#undef PG8_STAGE
#undef PG8_LDA
#undef PG8_LDB
#undef PG8_MMA
#undef PG8_WAIT_V
#undef PG8_WAIT_L
#undef PG8_BAR
#undef PG8_SCHED
}
}

#define LAS __attribute__((address_space(3)))
typedef unsigned short bf16;
typedef float f32x4 __attribute__((ext_vector_type(4)));
typedef float f32x2 __attribute__((ext_vector_type(2)));
typedef short bf16x8 __attribute__((ext_vector_type(8)));
typedef short bf16x4 __attribute__((ext_vector_type(4)));
typedef unsigned u32x4 __attribute__((ext_vector_type(4)));
typedef unsigned u32x2 __attribute__((ext_vector_type(2)));
using pg8::Unit;

constexpr int NWAVES = 8, NTHR = 512;
constexpr int NT = 16384, DM = 1024, FF = 2816;
constexpr float EPS = 1e-6f;
constexpr int LDS_BYTES = 147456;
constexpr size_t MiB = 1u << 20, KiB = 1024;
constexpr size_t WS_SSQ1 = 0, WS_SSQ2 = 1 * MiB, WS_SSQ3 = 2 * MiB, WS_SSQG = 3 * MiB;
constexpr size_t WS_BAR = 5 * MiB, BAR_BYTES = 32 * KiB;
constexpr size_t WS_N1M = 4 * MiB, WS_GUM = 4 * MiB + 64 * KiB, WS_H1MF = 4 * MiB + 448 * KiB, WS_PM = 4 * MiB + 512 * KiB, WS_ST0 = 4 * MiB + 640 * KiB, WS_ZM = 4 * MiB + 896 * KiB, WS_A16 = 4 * MiB + 928 * KiB;
constexpr size_t WS_WGU1 = 8 * MiB, WS_WD1 = 19 * MiB, WS_Y = 8 * MiB;
constexpr size_t WS_WMAIN = 25 * MiB, WS_H1B = 29 * MiB, WS_WKV = 61 * MiB, WS_KVT = 29 * MiB;
constexpr size_t WS_WGLU = 63 * MiB, WS_WOUT = 64 * MiB, WS_WGU2 = 66 * MiB, WS_WD2 = 77 * MiB, WS_WY = 83 * MiB, WS_WZ = 89 * MiB, WS_ROT = 93 * MiB;
constexpr size_t WS_ACT = 98 * MiB, WS_Q = 98 * MiB, WS_K = 114 * MiB, WS_G = 130 * MiB, WS_KWT = 146 * MiB, WS_VT = 162 * MiB;
constexpr size_t WS_N1 = 186 * MiB, WS_UA = 186 * MiB, WS_MIX = 186 * MiB, WS_Z = 218 * MiB, WS_SPT = 234 * MiB, WS_END = 250 * MiB;

struct Args { const float* in[26]; float* out; unsigned char* ws; int ph_lo, ph_hi; };

__device__ __forceinline__ unsigned pk2(float lo, float hi) { unsigned r; asm volatile("v_cvt_pk_bf16_f32 %0, %1, %2" : "=v"(r) : "v"(lo), "v"(hi)); return r; }
__device__ __forceinline__ u32x4 pk8(f32x4 a, f32x4 b) { u32x4 w; w.x = pk2(a[0], a[1]); w.y = pk2(a[2], a[3]); w.z = pk2(b[0], b[1]); w.w = pk2(b[2], b[3]); return w; }
__device__ __forceinline__ float bf2f(unsigned short b) { return __uint_as_float((unsigned)b << 16); }
__device__ __forceinline__ float bflo(unsigned w) { return __uint_as_float(w << 16); }
__device__ __forceinline__ float bfhi(unsigned w) { return __uint_as_float(w & 0xffff0000u); }
__device__ __forceinline__ float sigmoidf_(float x) { return __builtin_amdgcn_rcpf(1.0f + __expf(-x)); }
__device__ __forceinline__ float siluf_(float x) { return x * sigmoidf_(x); }
__device__ __forceinline__ float gelu_tanh(float y) { return y * sigmoidf_(1.5957691216057308f * (y + 0.044715f * y * y * y)); }
__device__ __forceinline__ float wave_sum(float v) {
#pragma unroll
    for (int o = 1; o < 64; o <<= 1) v += __shfl_xor(v, o);
    return v;
}
__device__ __forceinline__ float sum4(f32x4 a) { return (a[0] + a[1]) + (a[2] + a[3]); }
__device__ __forceinline__ float sumsq4(f32x4 a) { return (a[0] * a[0] + a[1] * a[1]) + (a[2] * a[2] + a[3] * a[3]); }
__device__ __forceinline__ float rstd16(const float* ssq, int row) { return 1.0f / sqrtf(ssq[row] * (1.0f / 1024.0f) + EPS); }
__device__ __forceinline__ float ms8(const float* ssq, int row) { return ssq[row] * (1.0f / 512.0f) + EPS; }
__device__ __forceinline__ void ssq_add(float* p, float v) { (void)__hip_atomic_fetch_add(p, v, __ATOMIC_RELAXED, __HIP_MEMORY_SCOPE_AGENT); }
__device__ __forceinline__ float log2gamma(int h) { return log2f(1.0f - exp2f(-5.0f - (float)h)); }
__device__ __forceinline__ f32x4 mfma16(bf16x8 a, bf16x8 b, f32x4 c) { return __builtin_amdgcn_mfma_f32_16x16x32_bf16(a, b, c, 0, 0, 0); }

enum { MAP_PLAIN = 0, MAP_GU0 = 1, MAP_GU1 = 2, MAP_ROT = 3 };
struct TJob { const float* W; int ldw, col0, ncols, k0, kcnt; bf16* dst; int ldt, map, row_off; const float* ks; int ks_off; };
__device__ __forceinline__ int map_row(int map, int row_off, int n) {
    if (map == MAP_PLAIN) return row_off + n;
    if (map == MAP_GU0) return 256 * (n >> 7) + (n & 127);
    if (map == MAP_GU1) return 256 * (n >> 7) + 128 + (n & 127);
    const int h = n >> 7, d = n & 127; return row_off + 256 * (h >> 1) + 128 * (d >> 6) + 64 * (h & 1) + (d & 63);
}
constexpr int NJOBS = 15;
__device__ __forceinline__ TJob get_job(int j, const Args& a) {
    unsigned char* ws = a.ws; TJob t;
    t.W = nullptr; t.ldw = 0; t.col0 = 0; t.ncols = 0; t.k0 = 0; t.kcnt = 0; t.dst = nullptr; t.ldt = 0; t.map = MAP_PLAIN; t.row_off = 0; t.ks = nullptr; t.ks_off = 0;
    switch (j) {
    case 0: t.W = a.in[3]; t.ldw = FF; t.ncols = FF; t.kcnt = DM; t.dst = (bf16*)(ws + WS_WGU1); t.ldt = DM; t.map = MAP_GU0; break;
    case 1: t.W = a.in[4]; t.ldw = FF; t.ncols = FF; t.kcnt = DM; t.dst = (bf16*)(ws + WS_WGU1); t.ldt = DM; t.map = MAP_GU1; break;
    case 2: t.W = a.in[5]; t.ldw = DM; t.ncols = DM; t.kcnt = FF; t.dst = (bf16*)(ws + WS_WD1); t.ldt = FF; break;
    case 3: t.W = a.in[7]; t.ldw = 2560; t.col0 = 0; t.ncols = 512; t.kcnt = DM; t.dst = (bf16*)(ws + WS_WMAIN); t.ldt = DM; t.map = MAP_ROT; t.row_off = 0; t.ks = a.in[6]; break;
    case 4: t.W = a.in[7]; t.ldw = 2560; t.col0 = 512; t.ncols = 512; t.kcnt = DM; t.dst = (bf16*)(ws + WS_WMAIN); t.ldt = DM; t.map = MAP_ROT; t.row_off = 512; t.ks = a.in[6]; break;
    case 5: t.W = a.in[7]; t.ldw = 2560; t.col0 = 1536; t.ncols = 512; t.kcnt = DM; t.dst = (bf16*)(ws + WS_WMAIN); t.ldt = DM; t.row_off = 1024; t.ks = a.in[6]; break;
    case 6: t.W = a.in[7]; t.ldw = 2560; t.col0 = 2048; t.ncols = 512; t.kcnt = DM; t.dst = (bf16*)(ws + WS_WMAIN); t.ldt = DM; t.row_off = 1536; t.ks = a.in[6]; break;
    case 7: t.W = a.in[7]; t.ldw = 2560; t.col0 = 512; t.ncols = 512; t.kcnt = DM; t.dst = (bf16*)(ws + WS_WKV); t.ldt = DM; t.map = MAP_ROT; t.row_off = 0; t.ks = a.in[6]; break;
    case 8: t.W = a.in[7]; t.ldw = 2560; t.col0 = 1024; t.ncols = 512; t.kcnt = DM; t.dst = (bf16*)(ws + WS_WKV); t.ldt = DM; t.row_off = 512; t.ks = a.in[6]; break;
    case 9: t.W = a.in[17]; t.ldw = 512; t.ncols = 512; t.kcnt = 512; t.dst = (bf16*)(ws + WS_WGLU); t.ldt = 512; break;
    case 10: t.W = a.in[20]; t.ldw = DM; t.ncols = DM; t.k0 = 0; t.kcnt = 512; t.dst = (bf16*)(ws + WS_WOUT); t.ldt = DM; break;
    case 11: t.W = a.in[20]; t.ldw = DM; t.ncols = DM; t.k0 = 512; t.kcnt = 512; t.dst = (bf16*)(ws + WS_WOUT); t.ldt = DM; t.ks = a.in[19]; t.ks_off = 512; break;
    case 12: t.W = a.in[22]; t.ldw = FF; t.ncols = FF; t.kcnt = DM; t.dst = (bf16*)(ws + WS_WGU2); t.ldt = DM; t.map = MAP_GU0; t.ks = a.in[21]; break;
    case 13: t.W = a.in[23]; t.ldw = FF; t.ncols = FF; t.kcnt = DM; t.dst = (bf16*)(ws + WS_WGU2); t.ldt = DM; t.map = MAP_GU1; t.ks = a.in[21]; break;
    default: t.W = a.in[24]; t.ldw = DM; t.ncols = DM; t.kcnt = FF; t.dst = (bf16*)(ws + WS_WD2); t.ldt = FF; break;
    }
    return t;
}
__device__ __forceinline__ void tr_item(const TJob& J, int item, LAS float* scr, int lane) {
    const int nblk = J.ncols >> 5, kb = item / nblk, nb = item - kb * nblk, k0 = J.k0 + 64 * kb, n0 = 32 * nb;
#pragma unroll
    for (int i = 0; i < 32; ++i) { const int kk = 2 * i + (lane >> 5); float v = J.W[(size_t)(k0 + kk) * J.ldw + J.col0 + n0 + (lane & 31)]; if (J.ks) v *= J.ks[k0 + kk - J.ks_off]; scr[kk * 33 + (lane & 31)] = v; }
    asm volatile("s_waitcnt lgkmcnt(0)" ::: "memory");
    const int c = lane & 7;
#pragma unroll
    for (int j = 0; j < 4; ++j) { const int n = (lane >> 3) + 8 * j; const LAS float* s = scr + (8 * c) * 33 + n;
        u32x4 o; o.x = pk2(s[0 * 33], s[1 * 33]); o.y = pk2(s[2 * 33], s[3 * 33]); o.z = pk2(s[4 * 33], s[5 * 33]); o.w = pk2(s[6 * 33], s[7 * 33]);
        *(u32x4*)(J.dst + (size_t)map_row(J.map, J.row_off, n0 + n) * J.ldt + k0 + 8 * c) = o; }
    asm volatile("s_waitcnt lgkmcnt(0)" ::: "memory");
}
__device__ __forceinline__ void tr_load(const TJob& J, int item, f32x2 (&r)[32], int lane) {
    const int nblk = J.ncols >> 7, kb = item / nblk, nb = item - kb * nblk, k0 = J.k0 + 32 * kb, n0 = 128 * nb;
    const float* wp = J.W + (size_t)k0 * J.ldw + J.col0 + n0 + 2 * lane;
    if (J.ks) { const float* kp = J.ks + (k0 - J.ks_off);
#pragma unroll
        for (int kk = 0; kk < 32; ++kk) r[kk] = *(const f32x2*)(wp + (size_t)kk * J.ldw) * kp[kk];
    } else {
#pragma unroll
        for (int kk = 0; kk < 32; ++kk) r[kk] = *(const f32x2*)(wp + (size_t)kk * J.ldw);
    }
}
__device__ __forceinline__ void tr_put(const f32x2 (&r)[32], LAS float* scr, int lane) {
#pragma unroll
    for (int kk = 0; kk < 32; ++kk) { scr[kk * 129 + 2 * lane] = r[kk].x; scr[kk * 129 + 2 * lane + 1] = r[kk].y; }
    asm volatile("s_waitcnt lgkmcnt(0)" ::: "memory");
}
__device__ __forceinline__ void tr_flush(const TJob& J, int item, LAS float* scr, int lane) {
    const int nblk = J.ncols >> 7, kb = item / nblk, nb = item - kb * nblk, k0 = J.k0 + 32 * kb, n0 = 128 * nb, c = lane & 3;
#pragma unroll
    for (int j = 0; j < 8; ++j) { const int n = (lane >> 2) + 16 * j; const LAS float* s = scr + (8 * c) * 129 + n;
        u32x4 o; o.x = pk2(s[0 * 129], s[1 * 129]); o.y = pk2(s[2 * 129], s[3 * 129]); o.z = pk2(s[4 * 129], s[5 * 129]); o.w = pk2(s[6 * 129], s[7 * 129]);
        *(u32x4*)(J.dst + (size_t)map_row(J.map, J.row_off, n0 + n) * J.ldt + k0 + 8 * c) = o; }
    asm volatile("s_waitcnt lgkmcnt(0)" ::: "memory");
}
struct TrIter { int it, j, base, cnt, jend, limit, valid, pad_; TJob J; };
__device__ __forceinline__ void tr_seek(TrIter& I, const Args& a) {
    while (I.j < I.jend && I.it >= I.base + I.cnt) { I.base += I.cnt; ++I.j; if (I.j < I.jend) { I.J = get_job(I.j, a); I.cnt = (I.J.kcnt >> 5) * (I.J.ncols >> 7); } }
    I.valid = (I.j < I.jend && I.it < I.limit) ? 1 : 0;
}
__device__ __forceinline__ void tr_run(const Args& a, int j0, int jend, int it0, int stride, LAS float* scr, int lane, int limit = 0x7fffffff) {
    TrIter I; I.it = it0; I.j = j0; I.base = 0; I.jend = jend; I.limit = limit; I.valid = 0; I.pad_ = 0; I.J = get_job(j0, a); I.cnt = (I.J.kcnt >> 5) * (I.J.ncols >> 7); tr_seek(I, a);
    f32x2 r[32];
    if (I.valid) tr_load(I.J, I.it - I.base, r, lane);
    while (I.valid) {
        TrIter N = I; N.it += stride; tr_seek(N, a);
        tr_put(r, scr, lane);
        if (N.valid) tr_load(N.J, N.it - N.base, r, lane);
        tr_flush(I.J, I.it - I.base, scr, lane);
        I = N;
    }
}
__device__ __forceinline__ void rms_rows4_to_bf16(const float* x0, size_t xstride, const float* w, bf16* o0, size_t ostride, int lane) {
    f32x4 v[4][4]; const f32x4* wr = (const f32x4*)w + lane;
#pragma unroll
    for (int q = 0; q < 4; ++q)
#pragma unroll
        for (int j = 0; j < 4; ++j) v[q][j] = ((const f32x4*)(x0 + q * xstride) + lane)[64 * j];
    float rs[4];
#pragma unroll
    for (int q = 0; q < 4; ++q) { float ss = 0.f;
#pragma unroll
        for (int j = 0; j < 4; ++j) ss += sumsq4(v[q][j]);
        rs[q] = 1.0f / sqrtf(wave_sum(ss) * (1.0f / 1024.0f) + EPS); }
#pragma unroll
    for (int j = 0; j < 4; ++j) { const f32x4 g = wr[64 * j];
#pragma unroll
        for (int q = 0; q < 4; ++q) { u32x2 o; o.x = pk2(v[q][j][0] * rs[q] * g[0], v[q][j][1] * rs[q] * g[1]); o.y = pk2(v[q][j][2] * rs[q] * g[2], v[q][j][3] * rs[q] * g[3]); ((u32x2*)(o0 + q * ostride) + lane)[64 * j] = o; } }
}
__device__ __forceinline__ void rms_row_to_bf16(const float* xrow, const float* w, bf16* orow, int lane) {
    const f32x4* xr = (const f32x4*)xrow + lane; const f32x4* wr = (const f32x4*)w + lane;
    f32x4 v[4]; float s = 0.f;
#pragma unroll
    for (int j = 0; j < 4; ++j) { v[j] = xr[64 * j]; s += sumsq4(v[j]); }
    const float rstd = 1.0f / sqrtf(wave_sum(s) * (1.0f / 1024.0f) + EPS);
    u32x2* o8 = (u32x2*)orow + lane;
#pragma unroll
    for (int j = 0; j < 4; ++j) { const f32x4 g = wr[64 * j]; u32x2 o; o.x = pk2(v[j][0] * rstd * g[0], v[j][1] * rstd * g[1]); o.y = pk2(v[j][2] * rstd * g[2], v[j][3] * rstd * g[3]); o8[64 * j] = o; }
}
__device__ __forceinline__ void rms_rows2_to_bf16(const float* xa, const float* xb, const float* w, bf16* oa, bf16* ob, int lane) {
    const f32x4* pa = (const f32x4*)xa + lane; const f32x4* pb = (const f32x4*)xb + lane; const f32x4* wr = (const f32x4*)w + lane;
    f32x4 va[4], vb[4]; float sa = 0.f, sb = 0.f;
#pragma unroll
    for (int j = 0; j < 4; ++j) { va[j] = pa[64 * j]; vb[j] = pb[64 * j]; }
#pragma unroll
    for (int j = 0; j < 4; ++j) { sa += sumsq4(va[j]); sb += sumsq4(vb[j]); }
    const float ra = 1.0f / sqrtf(wave_sum(sa) * (1.0f / 1024.0f) + EPS), rb = 1.0f / sqrtf(wave_sum(sb) * (1.0f / 1024.0f) + EPS);
    u32x2* qa = (u32x2*)oa + lane; u32x2* qb = (u32x2*)ob + lane;
#pragma unroll
    for (int j = 0; j < 4; ++j) { const f32x4 g = wr[64 * j]; u32x2 o; o.x = pk2(va[j][0] * ra * g[0], va[j][1] * ra * g[1]); o.y = pk2(va[j][2] * ra * g[2], va[j][3] * ra * g[3]); qa[64 * j] = o;
        o.x = pk2(vb[j][0] * rb * g[0], vb[j][1] * rb * g[1]); o.y = pk2(vb[j][2] * rb * g[2], vb[j][3] * rb * g[3]); qb[64 * j] = o; }
}
__device__ __forceinline__ f32x2 cmul(f32x2 a, f32x2 b) { return (f32x2){a.x * b.x - a.y * b.y, a.x * b.y + a.y * b.x}; }

__device__ __forceinline__ void ssm_mats(const Args& a, int g, LAS unsigned char* lds, int tid) {
    LAS f32x2* apow = (LAS f32x2*)lds;
    LAS f32x2* bbar = apow + 17 * 64;
    LAS f32x2* Cc = bbar + 1024;
    LAS float* Km = (LAS float*)(Cc + 1024);
    LAS f32x2* cfs = (LAS f32x2*)(Km + 4096);
    unsigned char* ws = a.ws;
    for (int idx = tid; idx < 17 * 64; idx += NTHR) {
        const int j = idx >> 6, n = idx & 63; const float lre = a.in[9][g * 64 + n], lim = a.in[10][g * 64 + n], dt = expf(a.in[11][g]);
        const float mag = expf((float)j * lre * dt); float sn, cs; sincosf((float)j * (lim * dt), &sn, &cs); const f32x2 ap = (f32x2){mag * cs, mag * sn}; apow[idx] = ap;
        if (j == 16) ((f32x2*)(ws + WS_A16))[g * 64 + n] = ap;
        if (j == 1) { const float nx = ap.x - 1.0f, ny = ap.y, den = lre * lre + lim * lim; cfs[n] = (f32x2){(nx * lre + ny * lim) / den, (ny * lre - nx * lim) / den}; }
    }
    __syncthreads();
    for (int idx = tid; idx < 1024; idx += NTHR) {
        { const int n = idx >> 4, q = idx & 15; const f32x2 b = (f32x2){a.in[12][(size_t)(g * 64 + n) * 16 + q], a.in[13][(size_t)(g * 64 + n) * 16 + q]}; bbar[idx] = cmul(cfs[n], b); }
        { const int p = idx >> 6, n = idx & 63; Cc[idx] = (f32x2){a.in[14][(size_t)(g * 16 + p) * 64 + n], a.in[15][(size_t)(g * 16 + p) * 64 + n]}; }
    }
    __syncthreads();
    {
        const int j = tid >> 5, p = (tid >> 1) & 15, qh = tid & 1; float acc[8];
#pragma unroll
        for (int q = 0; q < 8; ++q) acc[q] = 0.f;
        for (int n = 0; n < 64; ++n) { const f32x2 ca = cmul(Cc[p * 64 + n], apow[j * 64 + n]);
#pragma unroll
            for (int q = 0; q < 8; ++q) { const f32x2 b = bbar[n * 16 + qh * 8 + q]; acc[q] += ca.x * b.x - ca.y * b.y; } }
#pragma unroll
        for (int q = 0; q < 8; ++q) Km[(j * 16 + p) * 16 + qh * 8 + q] = acc[q];
    }
    __syncthreads();
    bf16* WY = (bf16*)(ws + WS_WY) + (size_t)g * 256 * 384; bf16* WZ = (bf16*)(ws + WS_WZ) + (size_t)g * 256 * 256;
    for (int idx = tid; idx < 256 * 192; idx += NTHR) {
        const int r = idx / 192, c = 2 * (idx - r * 192), t = r >> 4, p = r & 15; float v0, v1;
        if (c < 256) { const int s = c >> 4, q = c & 15; if (t >= s) { v0 = Km[((t - s) * 16 + p) * 16 + q]; v1 = Km[((t - s) * 16 + p) * 16 + q + 1]; } else { v0 = 0.f; v1 = 0.f; } }
        else { const int nn = c - 256, n = nn & 63; const f32x2 c0 = cmul(Cc[p * 64 + n], apow[(t + 1) * 64 + n]), c1 = cmul(Cc[p * 64 + n + 1], apow[(t + 1) * 64 + n + 1]);
            if (nn < 64) { v0 = c0.x; v1 = c1.x; } else { v0 = -c0.y; v1 = -c1.y; } }
        *(unsigned*)(WY + (size_t)r * 384 + c) = pk2(v0, v1);
    }
    for (int idx = tid; idx < 256 * 128; idx += NTHR) {
        const int r = idx >> 7, c = 2 * (idx & 127), s = c >> 4, q = c & 15; float v0 = 0.f, v1 = 0.f;
        if (r < 128) { const int n = r & 63; const f32x2 z0 = cmul(apow[(15 - s) * 64 + n], bbar[n * 16 + q]), z1 = cmul(apow[(15 - s) * 64 + n], bbar[n * 16 + q + 1]);
            if (r < 64) { v0 = z0.x; v1 = z1.x; } else { v0 = z0.y; v1 = z1.y; } }
        *(unsigned*)(WZ + (size_t)r * 256 + c) = pk2(v0, v1);
    }
    __syncthreads();
}

template <class AL, class EP>
__device__ __forceinline__ void skinny(const bf16* Bt, int ldb, int ngroups, int nsplit, int K, int task0, int ntask_stride, const AL& al, const EP& ep, int lane) {
    const int fr = lane & 15, fq = lane >> 4, kper = K / nsplit;
    for (int t = task0; t < ngroups * nsplit; t += ntask_stride) {
        const int grp = t % ngroups, sp = t / ngroups;
        f32x4 acc = (f32x4){0.f, 0.f, 0.f, 0.f};
        const bf16* bp = Bt + (size_t)(grp * 16 + fr) * ldb + fq * 8;
#pragma unroll 4
        for (int k = sp * kper; k < (sp + 1) * kper; k += 32) { const bf16x8 b = *(const bf16x8*)(bp + k); const bf16x8 av = al(fr, k + fq * 8); acc = mfma16(b, av, acc); }
        ep(fr, grp * 16 + fq * 4, acc);
    }
}
struct ALBf16 { const bf16* A; int lda; __device__ __forceinline__ bf16x8 operator()(int r, int k) const { return *(const bf16x8*)(A + (size_t)r * lda + k); } };
struct ALF32 { const float* A; int lda; __device__ __forceinline__ bf16x8 operator()(int r, int k) const { const f32x4* p = (const f32x4*)(A + (size_t)r * lda + k); return __builtin_bit_cast(bf16x8, pk8(p[0], p[1])); } };
struct ALSwiGLU { const float* GU; __device__ __forceinline__ bf16x8 operator()(int r, int k) const {
        const float* p = GU + (size_t)r * 5632 + 256 * (k >> 7) + (k & 127); const f32x4 g0 = *(const f32x4*)p, g1 = *(const f32x4*)(p + 4), u0 = *(const f32x4*)(p + 128), u1 = *(const f32x4*)(p + 132); f32x4 a0, a1;
#pragma unroll
        for (int e = 0; e < 4; ++e) { a0[e] = siluf_(g0[e]) * u0[e]; a1[e] = siluf_(g1[e]) * u1[e]; }
        return __builtin_bit_cast(bf16x8, pk8(a0, a1)); } };
struct EPStore { float* O; int ldo; __device__ __forceinline__ void operator()(int r, int c, f32x4 v) const { *(f32x4*)(O + (size_t)r * ldo + c) = v; } };
struct EPAtomic { float* O; int ldo; float sc; __device__ __forceinline__ void operator()(int r, int c, f32x4 v) const { float* p = O + (size_t)r * ldo + c;
#pragma unroll
        for (int e = 0; e < 4; ++e) ssq_add(p + e, sc * v[e]); } };

struct P3Order {
    int G, c;
    __device__ bool next(int i, Unit& u) const {
        if (G == 256) { if (i > 2) return false; const int c4 = c >> 2, sub = c & 3;
            if (i < 2) { u.pm = c4; u.pn = (sub < 2) ? (4 + 2 * i + sub) : (2 * i + sub - 2); } else { u.pn = 8 + c4; u.pm = 64 + sub; } return true; }
        const int L = i * G + c; if (L >= 768) return false;
        if (L < 512) { u.pm = L >> 3; u.pn = L & 7; } else { const int l = L - 512; u.pn = 8 + (l >> 2); u.pm = 64 + (l & 3); } return true; }
    __device__ __forceinline__ void a_ready(const Unit&) const {}
    __device__ __forceinline__ void done(const Unit&) const {}
};
struct GroupOrder {
    int G, c;
    __device__ bool next(int i, Unit& u) const { const int L = i * G + c; if (L >= 128) return false; u.pm = L; u.pn = L >> 2; return true; }
    __device__ __forceinline__ void a_ready(const Unit&) const {}
    __device__ __forceinline__ void done(const Unit&) const {}
};

struct EpiSwiGLU {
    static constexpr bool PERM = true, AFTER_DRAIN = false, HAS_MID = false;
    bf16* O; const float* ssq;
    __device__ __forceinline__ void operator()(const f32x4 (&acc)[2][2][4][2], const Unit& u, int wr, int wc, int fr, int fq) const {
        asm volatile("" : "+v"(fr), "+v"(fq));
        const int col0 = u.pn * 128 + wc * 32 + 8 * fq;
#pragma unroll
        for (int ai = 0; ai < 2; ++ai)
#pragma unroll
            for (int m = 0; m < 4; ++m) { const int row = u.pm * 256 + ai * 128 + wr * 64 + m * 16 + fr; const float rs = ssq ? rstd16(ssq, row) : 1.0f;
                f32x4 a0, a1;
#pragma unroll
                for (int e = 0; e < 4; ++e) { a0[e] = siluf_(acc[ai][0][m][0][e] * rs) * (acc[ai][1][m][0][e] * rs); a1[e] = siluf_(acc[ai][0][m][1][e] * rs) * (acc[ai][1][m][1][e] * rs); }
                *(u32x4*)(O + (size_t)row * FF + col0) = pk8(a0, a1); asm volatile("" ::: "memory"); }
    }
};
template <int MODE>
struct EpiRes {
    static constexpr bool PERM = true, AFTER_DRAIN = false, HAS_MID = (MODE == 1); static constexpr int MID_T = 8;
    const float* base; float* out; bf16* hb; float* ssq_out; const float* ssqg;
    __device__ __forceinline__ void mid(f32x4 (&acc)[2][2][4][2], const Unit& u, int wr, int fr) const {
#pragma unroll
        for (int ai = 0; ai < 2; ++ai)
#pragma unroll
            for (int m = 0; m < 4; ++m) { const int row = u.pm * 256 + ai * 128 + wr * 64 + m * 16 + fr; const float f = sqrtf(ms8(ssqg, row));
#pragma unroll
                for (int bj = 0; bj < 2; ++bj)
#pragma unroll
                    for (int n = 0; n < 2; ++n) acc[ai][bj][m][n] = acc[ai][bj][m][n] * f; }
    }
    __device__ __forceinline__ void operator()(const f32x4 (&acc)[2][2][4][2], const Unit& u, int wr, int wc, int fr, int fq) const {
        asm volatile("" : "+v"(fr), "+v"(fq));
#pragma unroll
        for (int ai = 0; ai < 2; ++ai)
#pragma unroll
            for (int m = 0; m < 4; ++m) { const int row = u.pm * 256 + ai * 128 + wr * 64 + m * 16 + fr; const float sc = MODE == 0 ? 0.5f : 1.0f / sqrtf(ms8(ssqg, row)); float ss = 0.f;
#pragma unroll
                for (int bj = 0; bj < 2; ++bj) { const size_t off = (size_t)row * DM + u.pn * 256 + bj * 128 + wc * 32 + 8 * fq;
                    const f32x4 b0 = *(const f32x4*)(base + off), b1 = *(const f32x4*)(base + off + 4); const f32x4 h0 = b0 + sc * acc[ai][bj][m][0], h1 = b1 + sc * acc[ai][bj][m][1];
                    *(f32x4*)(out + off) = h0; *(f32x4*)(out + off + 4) = h1; if (hb) *(u32x4*)(hb + off) = pk8(h0, h1); ss += sumsq4(h0) + sumsq4(h1); }
                ss += __shfl_xor(ss, 16); ss += __shfl_xor(ss, 32);
                if (fq == 0) ssq_add(ssq_out + row, ss); asm volatile("" ::: "memory"); }
    }
};
struct EpiFinal {
    static constexpr bool PERM = true, AFTER_DRAIN = false, HAS_MID = false;
    const float* base; float* out; float* ssq; unsigned* cnt; const float* w;
    __device__ __forceinline__ void operator()(f32x4 (&acc)[2][2][4][2], const Unit& u, int wr, int wc, int fr, int fq) const {
        asm volatile("" : "+v"(fr), "+v"(fq));
#pragma unroll
        for (int ai = 0; ai < 2; ++ai)
#pragma unroll
            for (int m = 0; m < 4; ++m) { const int row = u.pm * 256 + ai * 128 + wr * 64 + m * 16 + fr; float ss = 0.f;
#pragma unroll
                for (int bj = 0; bj < 2; ++bj) { const size_t off = (size_t)row * DM + u.pn * 256 + bj * 128 + wc * 32 + 8 * fq;
                    const f32x4 b0 = *(const f32x4*)(base + off), b1 = *(const f32x4*)(base + off + 4); const f32x4 h0 = b0 + 0.5f * acc[ai][bj][m][0], h1 = b1 + 0.5f * acc[ai][bj][m][1];
                    acc[ai][bj][m][0] = h0; acc[ai][bj][m][1] = h1; ss += sumsq4(h0) + sumsq4(h1); }
                ss += __shfl_xor(ss, 16); ss += __shfl_xor(ss, 32);
                if (fq == 0) ssq_add(ssq + row, ss); asm volatile("" ::: "memory"); }
        asm volatile("s_waitcnt vmcnt(0)" ::: "memory");
        unsigned* c = cnt + 64 * u.pm;
        if (fr == 0 && fq == 0) (void)__hip_atomic_fetch_add(c, 1u, __ATOMIC_RELAXED, __HIP_MEMORY_SCOPE_AGENT);
        for (unsigned sp = 0; sp < (1u << 20); ++sp) { if ((unsigned)__builtin_amdgcn_readfirstlane(__hip_atomic_load(c, __ATOMIC_RELAXED, __HIP_MEMORY_SCOPE_AGENT)) >= 32u) break; __builtin_amdgcn_s_sleep(2); }
        asm volatile("" ::: "memory");
#pragma unroll
        for (int ai = 0; ai < 2; ++ai)
#pragma unroll
            for (int m = 0; m < 4; ++m) { const int row = u.pm * 256 + ai * 128 + wr * 64 + m * 16 + fr;
                const float rs = 1.0f / sqrtf(__hip_atomic_load(ssq + row, __ATOMIC_RELAXED, __HIP_MEMORY_SCOPE_AGENT) * (1.0f / 1024.0f) + EPS);
#pragma unroll
                for (int bj = 0; bj < 2; ++bj) { const int col = u.pn * 256 + bj * 128 + wc * 32 + 8 * fq; const size_t off = (size_t)row * DM + col;
                    const f32x4 w0 = *(const f32x4*)(w + col), w1 = *(const f32x4*)(w + col + 4);
                    *(f32x4*)(out + off) = acc[ai][bj][m][0] * rs * w0; *(f32x4*)(out + off + 4) = acc[ai][bj][m][1] * rs * w1; }
                asm volatile("" ::: "memory"); }
    }
};
struct EpiInProj {
    static constexpr bool PERM = true, AFTER_DRAIN = false, HAS_MID = false;
    const float* ssq1; const f32x2* rot; bf16 *Q, *K, *G, *UA, *KWT, *VT;
    __device__ __forceinline__ void operator()(const f32x4 (&acc)[2][2][4][2], const Unit& u, int wr, int wc, int fr, int fq) const {
        asm volatile("" : "+v"(fr), "+v"(fq));
        if (u.pm < 64) {
#ifndef NO_NORMAL
            const int pn = u.pn;
            if (pn < 4) {
                bf16* O = pn < 2 ? Q : K; const float sc = pn < 2 ? 1.0f : 0.08838834764831845f; const int p0 = wc * 32 + 8 * fq, head = 2 * (pn & 1) + (p0 >> 6), i0 = p0 & 63;
#pragma unroll
                for (int ai = 0; ai < 2; ++ai)
#pragma unroll
                    for (int m = 0; m < 4; ++m) { const int row = u.pm * 256 + ai * 128 + wr * 64 + m * 16 + fr; const float rs = rstd16(ssq1, row) * sc; const int pos = 16 + (row & 8191);
                        const f32x4* rp = (const f32x4*)(rot + (size_t)pos * 64 + i0); f32x4 o1[2], o2[2];
#pragma unroll
                        for (int n = 0; n < 2; ++n) { const f32x4 ra = rp[2 * n], rb = rp[2 * n + 1]; const f32x4 x1 = acc[ai][0][m][n], x2 = acc[ai][1][m][n];
                            o1[n][0] = (x1[0] * ra[0] - x2[0] * ra[1]) * rs; o2[n][0] = (x1[0] * ra[1] + x2[0] * ra[0]) * rs;
                            o1[n][1] = (x1[1] * ra[2] - x2[1] * ra[3]) * rs; o2[n][1] = (x1[1] * ra[3] + x2[1] * ra[2]) * rs;
                            o1[n][2] = (x1[2] * rb[0] - x2[2] * rb[1]) * rs; o2[n][2] = (x1[2] * rb[1] + x2[2] * rb[0]) * rs;
                            o1[n][3] = (x1[3] * rb[2] - x2[3] * rb[3]) * rs; o2[n][3] = (x1[3] * rb[3] + x2[3] * rb[2]) * rs; }
                        bf16* op = O + (size_t)row * 512 + head * 128 + i0; *(u32x4*)op = pk8(o1[0], o1[1]); *(u32x4*)(op + 64) = pk8(o2[0], o2[1]); asm volatile("" ::: "memory"); if (m & 1) __builtin_amdgcn_sched_barrier(0); }
            } else if (pn < 6) {
#pragma unroll
                for (int ai = 0; ai < 2; ++ai)
#pragma unroll
                    for (int m = 0; m < 4; ++m) { const int row = u.pm * 256 + ai * 128 + wr * 64 + m * 16 + fr; const float rs = rstd16(ssq1, row);
#pragma unroll
                        for (int bj = 0; bj < 2; ++bj) *(u32x4*)(G + (size_t)row * 512 + (pn - 4) * 256 + bj * 128 + wc * 32 + 8 * fq) = pk8(acc[ai][bj][m][0] * rs, acc[ai][bj][m][1] * rs); }
            } else {
#pragma unroll
                for (int ai = 0; ai < 2; ++ai)
#pragma unroll
                    for (int m = 0; m < 4; ++m) { const int row = u.pm * 256 + ai * 128 + wr * 64 + m * 16 + fr; const float rs = rstd16(ssq1, row); const int chunk = row >> 4, s = row & 15;
#pragma unroll
                        for (int bj = 0; bj < 2; ++bj) { const int ch = (pn - 6) * 256 + bj * 128 + wc * 32 + 8 * fq;
                            *(u32x4*)(UA + ((size_t)(ch >> 4) * 1024 + chunk) * 384 + s * 16 + (ch & 15)) = pk8(acc[ai][bj][m][0] * rs, acc[ai][bj][m][1] * rs); } }
            }
#endif
        } else {
#ifndef NO_SWAP
            const int tokb = (u.pn - 8) * 256 + wc * 32 + 8 * fq;
            if (u.pm < 66) {
                const int head = 2 * (u.pm - 64) + wr; const float l2g = log2gamma(head);
#pragma unroll
                for (int bj = 0; bj < 2; ++bj) { const int tok0 = tokb + bj * 128; float rs[8];
#pragma unroll
                    for (int e = 0; e < 8; ++e) rs[e] = rstd16(ssq1, tok0 + e) * 0.08838834764831845f * exp2f(l2g * (float)(127 - ((tok0 + e) & 127)));
#pragma unroll
                    for (int m = 0; m < 4; ++m) { const int i = 16 * m + fr; f32x4 o1[2], o2[2];
#pragma unroll
                        for (int e = 0; e < 8; ++e) { const int pos = 16 + ((tok0 + e) & 8191); const f32x2 cs = rot[(size_t)pos * 64 + i]; const float x1 = acc[0][bj][m][e >> 2][e & 3], x2 = acc[1][bj][m][e >> 2][e & 3];
                            o1[e >> 2][e & 3] = (x1 * cs.x - x2 * cs.y) * rs[e]; o2[e >> 2][e & 3] = (x1 * cs.y + x2 * cs.x) * rs[e]; }
                        *(u32x4*)(KWT + (size_t)(head * 128 + i) * NT + tok0) = pk8(o1[0], o1[1]); *(u32x4*)(KWT + (size_t)(head * 128 + 64 + i) * NT + tok0) = pk8(o2[0], o2[1]); asm volatile("" ::: "memory"); __builtin_amdgcn_sched_barrier(0); } }
            } else {
#pragma unroll
                for (int bj = 0; bj < 2; ++bj) { const int tok0 = tokb + bj * 128; f32x4 r0, r1;
#pragma unroll
                    for (int e = 0; e < 4; ++e) { r0[e] = rstd16(ssq1, tok0 + e); r1[e] = rstd16(ssq1, tok0 + 4 + e); }
#pragma unroll
                    for (int ai = 0; ai < 2; ++ai)
#pragma unroll
                        for (int m = 0; m < 4; ++m) { const int r = (u.pm - 66) * 256 + ai * 128 + wr * 64 + m * 16 + fr; *(u32x4*)(VT + (size_t)r * NT + tok0) = pk8(acc[ai][bj][m][0] * r0, acc[ai][bj][m][1] * r1); } }
            }
#endif
        }
    }
};
struct EpiZ {
    static constexpr bool PERM = true, AFTER_DRAIN = false, HAS_MID = false;
    float* Z;
    __device__ __forceinline__ void operator()(const f32x4 (&acc)[2][2][4][2], const Unit& u, int wr, int wc, int fr, int fq) const {
        asm volatile("" : "+v"(fr), "+v"(fq));
#pragma unroll
        for (int ai = 0; ai < 2; ++ai)
#pragma unroll
            for (int m = 0; m < 4; ++m) { const int row = u.pm * 256 + ai * 128 + wr * 64 + m * 16 + fr; float* p = Z + (size_t)row * 128 + wc * 32 + 8 * fq; *(f32x4*)p = acc[ai][0][m][0]; *(f32x4*)(p + 4) = acc[ai][0][m][1]; }
    }
};
struct EpiY {
    static constexpr bool PERM = true, AFTER_DRAIN = false, HAS_MID = false;
    const bf16* UA; const float* D; bf16* Y;
    __device__ __forceinline__ void operator()(const f32x4 (&acc)[2][2][4][2], const Unit& u, int wr, int wc, int fr, int fq) const {
        asm volatile("" : "+v"(fr), "+v"(fq));
        const int grp = u.pn, p0 = 8 * (fq & 1);
        const bf16* ub = UA + (size_t)(u.pm * 256 + wr * 64 + fr) * 384 + wc * 32 + 8 * fq;
        bf16* yb = Y + (size_t)((((u.pm & 3) * 256 + wr * 64 + fr) * 16) + wc * 2 + (fq >> 1)) * 512 + grp * 16 + p0;
        const f32x4 d0 = *(const f32x4*)(D + grp * 16 + p0), d1 = *(const f32x4*)(D + grp * 16 + p0 + 4);
#pragma unroll
        for (int ai = 0; ai < 2; ++ai)
#pragma unroll
            for (int m = 0; m < 4; ++m) {
#pragma unroll
                for (int bj = 0; bj < 2; ++bj) {
                    const u32x4 uv = *(const u32x4*)(ub + (ai * 128 + m * 16) * 384 + bj * 128);
                    f32x4 y0 = acc[ai][bj][m][0], y1 = acc[ai][bj][m][1];
                    y0[0] += d0[0] * bflo(uv.x); y0[1] += d0[1] * bfhi(uv.x); y0[2] += d0[2] * bflo(uv.y); y0[3] += d0[3] * bfhi(uv.y);
                    y1[0] += d1[0] * bflo(uv.z); y1[1] += d1[1] * bfhi(uv.z); y1[2] += d1[2] * bflo(uv.w); y1[3] += d1[3] * bfhi(uv.w);
#pragma unroll
                    for (int e = 0; e < 4; ++e) { y0[e] = gelu_tanh(y0[e]); y1[e] = gelu_tanh(y1[e]); }
                    *(u32x4*)(yb + (size_t)((ai * 128 + m * 16) * 16 + bj * 8) * 512) = pk8(y0, y1); __builtin_amdgcn_sched_barrier(0); }
                asm volatile("" ::: "memory"); }
    }
};
struct EpiGLU {
    static constexpr bool PERM = true, AFTER_DRAIN = false, HAS_MID = false;
    const bf16* Y; const float* bias; bf16* MIX; float* ssqg;
    __device__ __forceinline__ void operator()(const f32x4 (&acc)[2][2][4][2], const Unit& u, int wr, int wc, int fr, int fq) const {
        asm volatile("" : "+v"(fr), "+v"(fq));
#pragma unroll
        for (int ai = 0; ai < 2; ++ai)
#pragma unroll
            for (int m = 0; m < 4; ++m) { const int row = u.pm * 256 + ai * 128 + wr * 64 + m * 16 + fr; float ss = 0.f;
#pragma unroll
                for (int bj = 0; bj < 2; ++bj) { const int col = u.pn * 256 + bj * 128 + wc * 32 + 8 * fq;
                    const u32x4 yv = *(const u32x4*)(Y + (size_t)row * 512 + col); const f32x4 b0 = *(const f32x4*)(bias + col), b1 = *(const f32x4*)(bias + col + 4);
                    const f32x4 z0 = acc[ai][bj][m][0] + b0, z1 = acc[ai][bj][m][1] + b1; f32x4 y0, y1;
                    y0[0] = bflo(yv.x) * sigmoidf_(z0[0]); y0[1] = bfhi(yv.x) * sigmoidf_(z0[1]); y0[2] = bflo(yv.y) * sigmoidf_(z0[2]); y0[3] = bfhi(yv.y) * sigmoidf_(z0[3]);
                    y1[0] = bflo(yv.z) * sigmoidf_(z1[0]); y1[1] = bfhi(yv.z) * sigmoidf_(z1[1]); y1[2] = bflo(yv.w) * sigmoidf_(z1[2]); y1[3] = bfhi(yv.w) * sigmoidf_(z1[3]);
                    ss += sumsq4(y0) + sumsq4(y1); *(u32x4*)(MIX + (size_t)row * DM + 512 + col) = pk8(y0, y1); }
                ss += __shfl_xor(ss, 16); ss += __shfl_xor(ss, 32);
                if (fq == 0) ssq_add(ssqg + row, ss); asm volatile("" ::: "memory"); }
    }
};

#define LD16(off) (*(const bf16x8*)(ws + (off)))
#define LD8(off) (*(const u32x2*)(ws + (off)))
__device__ __forceinline__ void r1_item(int item, unsigned char* ws, int w, int lane) {
    const int bh = item >> 6, n = item & 63, b = bh >> 2, h = bh & 3, fr = lane & 15, fq = lane >> 4; const int tok0 = b * 8192 + n * 128;
    const unsigned voff = (unsigned)WS_VT + (unsigned)(((h * 128 + 16 * w + fr) * NT + tok0 + 8 * fq) * 2);
    const unsigned koff = (unsigned)WS_KWT + (unsigned)(((h * 128 + fr) * NT + tok0 + 8 * fq) * 2);
    bf16x8 vf[4];
#pragma unroll
    for (int ks = 0; ks < 4; ++ks) vf[ks] = LD16(voff + 64 * ks);
    const unsigned ooff = (unsigned)WS_KVT + (unsigned)((((bh * 64 + n) * 128 + 16 * w + 4 * fq) * 128 + fr) * 4);
#pragma unroll
    for (int dt = 0; dt < 8; ++dt) { f32x4 acc = (f32x4){0.f, 0.f, 0.f, 0.f};
#pragma unroll
        for (int ks = 0; ks < 4; ++ks) acc = mfma16(vf[ks], LD16(koff + (unsigned)(dt * 16 * NT * 2 + 64 * ks)), acc);
#pragma unroll
        for (int jj = 0; jj < 4; ++jj) *(float*)(ws + ooff + (unsigned)((jj * 128 + 16 * dt) * 4)) = acc[jj]; }
}
__device__ __forceinline__ void r3_item(int item, unsigned char* ws, const float* retw, int w, int lane) {
    const int bh = item >> 6, n = item & 63, b = bh >> 2, h = bh & 3, fr = lane & 15, fq = lane >> 4; const int tok0 = b * 8192 + n * 128, irow = tok0 + 16 * w + fr;
    const float l2g = log2gamma(h);
    const unsigned qoff = (unsigned)WS_Q + (unsigned)((irow * 512 + h * 128 + 8 * fq) * 2);
    const unsigned koff = (unsigned)WS_K + (unsigned)(((tok0 + fr) * 512 + h * 128 + 8 * fq) * 2);
    const unsigned voff = (unsigned)WS_VT + (unsigned)(((h * 128 + fr) * NT + tok0 + 4 * fq) * 2);
    const unsigned soff = (unsigned)WS_SPT + (unsigned)((((bh * 64 + n) * 128 + fr) * 128 + 8 * fq) * 2);
    const unsigned goff = (unsigned)WS_G + (unsigned)((irow * 512 + h * 128 + 4 * fq) * 2);
    const unsigned moff = (unsigned)WS_MIX + (unsigned)((irow * 1024 + h * 128 + 4 * fq) * 2);
    bf16x8 qf[4];
#pragma unroll
    for (int ks = 0; ks < 4; ++ks) qf[ks] = LD16(qoff + 64 * ks);
    f32x4 s[8];
#pragma unroll
    for (int jt = 0; jt < 8; ++jt) { s[jt] = (f32x4){0.f, 0.f, 0.f, 0.f};
        if (jt <= w) {
#pragma unroll
            for (int ks = 0; ks < 4; ++ks) s[jt] = mfma16(LD16(koff + (unsigned)(jt * 16 * 512 * 2 + 64 * ks)), qf[ks], s[jt]);
#pragma unroll
            for (int jj = 0; jj < 4; ++jj) { const int dd = 16 * (w - jt) + fr - 4 * fq - jj; s[jt][jj] = dd >= 0 ? s[jt][jj] * exp2f(l2g * (float)dd) : 0.f; } } }
    f32x4 o[8];
#pragma unroll
    for (int et = 0; et < 8; ++et) o[et] = (f32x4){0.f, 0.f, 0.f, 0.f};
#pragma unroll
    for (int kp = 0; kp < 4; ++kp) if (2 * kp <= w) { const bf16x8 sf = __builtin_bit_cast(bf16x8, pk8(s[2 * kp], s[2 * kp + 1]));
#pragma unroll
        for (int et = 0; et < 8; ++et) { const u32x2 v0 = LD8(voff + (unsigned)(et * 16 * NT * 2 + 64 * kp)), v1 = LD8(voff + (unsigned)(et * 16 * NT * 2 + 64 * kp + 32));
            const u32x4 vv = (u32x4){v0.x, v0.y, v1.x, v1.y}; o[et] = mfma16(__builtin_bit_cast(bf16x8, vv), sf, o[et]); } }
    const float wq = exp2f(l2g * (float)(16 * w + fr + 1)); float s1 = 0.f;
#pragma unroll
    for (int et = 0; et < 8; ++et) { f32x4 oc = (f32x4){0.f, 0.f, 0.f, 0.f};
#pragma unroll
        for (int ks = 0; ks < 4; ++ks) oc = mfma16(LD16(soff + (unsigned)(et * 16 * 128 * 2 + 64 * ks)), qf[ks], oc);
        o[et] = o[et] + wq * oc; s1 += sum4(o[et]); }
    s1 += __shfl_xor(s1, 16); s1 += __shfl_xor(s1, 32); const float mean = s1 * (1.0f / 128.0f); float s2 = 0.f;
#pragma unroll
    for (int et = 0; et < 8; ++et) { o[et] = o[et] - mean; s2 += sumsq4(o[et]); }
    s2 += __shfl_xor(s2, 16); s2 += __shfl_xor(s2, 32);
    const float msg = *(const float*)(ws + (unsigned)WS_SSQG + (unsigned)(irow * 4)) * (1.0f / 512.0f) + EPS;
    const float sc = (1.0f / sqrtf(s2 * (1.0f / 128.0f) + EPS)) * sqrtf(msg);
    const float* wnp = retw + h * 128 + 4 * fq;
#pragma unroll
    for (int et = 0; et < 8; ++et) { const f32x4 wn = *(const f32x4*)(wnp + 16 * et); const u32x2 gv = LD8(goff + 32 * et);
        u32x2 ov; ov.x = pk2(o[et][0] * sc * wn[0] * siluf_(bflo(gv.x)), o[et][1] * sc * wn[1] * siluf_(bfhi(gv.x))); ov.y = pk2(o[et][2] * sc * wn[2] * siluf_(bflo(gv.y)), o[et][3] * sc * wn[3] * siluf_(bfhi(gv.y)));
        *(u32x2*)(ws + moff + 32 * et) = ov; }
}
constexpr int RT_PITCH = 272, RT_TILE = 128 * RT_PITCH;
__device__ __forceinline__ void rt_load(u32x4 (&r)[4], const unsigned char* ws, unsigned goff, unsigned gpitch, int tid) {
#pragma unroll
    for (int i = 0; i < 4; ++i) { const int c = tid + 512 * i; r[i] = *(const u32x4*)(ws + goff + (unsigned)(c >> 4) * gpitch + (unsigned)(c & 15) * 16u); }
}
__device__ __forceinline__ void rt_store(const u32x4 (&r)[4], LAS unsigned char* t, int tid) {
#pragma unroll
    for (int i = 0; i < 4; ++i) { const int c = tid + 512 * i; *(LAS u32x4*)(t + (c >> 4) * RT_PITCH + (c & 15) * 16) = r[i]; }
}
#define LF16(t, row, col) (*(const LAS bf16x8*)((t) + (row) * RT_PITCH + (col) * 2))
#define LF8(t, row, col) (*(const LAS u32x2*)((t) + (row) * RT_PITCH + (col) * 2))
__device__ __forceinline__ void r1_item_lds(int item, unsigned char* ws, LAS unsigned char* lds, int w, int lane, int tid) {
    const int bh = item >> 6, n = item & 63, b = bh >> 2, h = bh & 3, fr = lane & 15, fq = lane >> 4; const int tok0 = b * 8192 + n * 128;
    LAS unsigned char* Vs = lds; LAS unsigned char* Ks = lds + RT_TILE;
    { u32x4 rv[4], rk[4];
      rt_load(rv, ws, (unsigned)WS_VT + (unsigned)((h * 128 * NT + tok0) * 2), NT * 2, tid); rt_load(rk, ws, (unsigned)WS_KWT + (unsigned)((h * 128 * NT + tok0) * 2), NT * 2, tid);
      rt_store(rv, Vs, tid); rt_store(rk, Ks, tid); }
    __syncthreads();
    bf16x8 vf[4];
#pragma unroll
    for (int ks = 0; ks < 4; ++ks) vf[ks] = LF16(Vs, 16 * w + fr, 32 * ks + 8 * fq);
    const unsigned ooff = (unsigned)WS_KVT + (unsigned)((((bh * 64 + n) * 128 + 16 * w + 4 * fq) * 128 + fr) * 4);
#pragma unroll
    for (int dt = 0; dt < 8; ++dt) { f32x4 acc = (f32x4){0.f, 0.f, 0.f, 0.f};
#pragma unroll
        for (int ks = 0; ks < 4; ++ks) acc = mfma16(vf[ks], LF16(Ks, 16 * dt + fr, 32 * ks + 8 * fq), acc);
#pragma unroll
        for (int jj = 0; jj < 4; ++jj) *(float*)(ws + ooff + (unsigned)((jj * 128 + 16 * dt) * 4)) = acc[jj]; }
    __syncthreads();
}
struct R3Regs { u32x4 rq[4], rk[4], rv[4], rs[4]; };
__device__ __forceinline__ void r3_loads(int item, const unsigned char* ws, R3Regs& R, int tid) {
    const int bh = item >> 6, n = item & 63, b = bh >> 2, h = bh & 3; const int tok0 = b * 8192 + n * 128;
    rt_load(R.rq, ws, (unsigned)WS_Q + (unsigned)((tok0 * 512 + h * 128) * 2), 1024, tid); rt_load(R.rk, ws, (unsigned)WS_K + (unsigned)((tok0 * 512 + h * 128) * 2), 1024, tid);
    rt_load(R.rv, ws, (unsigned)WS_VT + (unsigned)((h * 128 * NT + tok0) * 2), NT * 2, tid); rt_load(R.rs, ws, (unsigned)WS_SPT + (unsigned)((bh * 64 + n) * 16384 * 2), 256, tid);
}
__device__ __forceinline__ void r3_item_pipe(int item, int nxt, R3Regs& R, unsigned char* ws, const float* retw, LAS unsigned char* lds, int w, int lane, int tid) {
    const int bh = item >> 6, n = item & 63, b = bh >> 2, h = bh & 3, fr = lane & 15, fq = lane >> 4; const int tok0 = b * 8192 + n * 128, irow = tok0 + 16 * w + fr;
    const float l2g = log2gamma(h);
    LAS unsigned char* Qs = lds; LAS unsigned char* Ks = lds + RT_TILE; LAS unsigned char* Vs = lds + 2 * RT_TILE; LAS unsigned char* Ss = lds + 3 * RT_TILE;
    rt_store(R.rq, Qs, tid); rt_store(R.rk, Ks, tid); rt_store(R.rv, Vs, tid); rt_store(R.rs, Ss, tid);
    if (nxt >= 0) r3_loads(nxt, ws, R, tid);
    const unsigned goff = (unsigned)WS_G + (unsigned)((irow * 512 + h * 128 + 4 * fq) * 2);
    const unsigned moff = (unsigned)WS_MIX + (unsigned)((irow * 1024 + h * 128 + 4 * fq) * 2);
    u32x2 gv[8];
#pragma unroll
    for (int et = 0; et < 8; ++et) gv[et] = *(const u32x2*)(ws + goff + 32 * et);
    __syncthreads();
    bf16x8 qf[4];
#pragma unroll
    for (int ks = 0; ks < 4; ++ks) qf[ks] = LF16(Qs, 16 * w + fr, 32 * ks + 8 * fq);
    f32x4 s[8];
#pragma unroll
    for (int jt = 0; jt < 8; ++jt) { s[jt] = (f32x4){0.f, 0.f, 0.f, 0.f};
        if (jt <= w) {
#pragma unroll
            for (int ks = 0; ks < 4; ++ks) s[jt] = mfma16(LF16(Ks, 16 * jt + fr, 32 * ks + 8 * fq), qf[ks], s[jt]);
#pragma unroll
            for (int jj = 0; jj < 4; ++jj) { const int dd = 16 * (w - jt) + fr - 4 * fq - jj; s[jt][jj] = dd >= 0 ? s[jt][jj] * exp2f(l2g * (float)dd) : 0.f; } } }
    f32x4 o[8];
#pragma unroll
    for (int et = 0; et < 8; ++et) o[et] = (f32x4){0.f, 0.f, 0.f, 0.f};
#pragma unroll
    for (int kp = 0; kp < 4; ++kp) if (2 * kp <= w) { const bf16x8 sf = __builtin_bit_cast(bf16x8, pk8(s[2 * kp], s[2 * kp + 1]));
#pragma unroll
        for (int et = 0; et < 8; ++et) { const u32x2 v0 = LF8(Vs, 16 * et + fr, 32 * kp + 4 * fq), v1 = LF8(Vs, 16 * et + fr, 32 * kp + 16 + 4 * fq);
            const u32x4 vv = (u32x4){v0.x, v0.y, v1.x, v1.y}; o[et] = mfma16(__builtin_bit_cast(bf16x8, vv), sf, o[et]); } }
    const float wq = exp2f(l2g * (float)(16 * w + fr + 1)); float s1 = 0.f;
#pragma unroll
    for (int et = 0; et < 8; ++et) { f32x4 oc = (f32x4){0.f, 0.f, 0.f, 0.f};
#pragma unroll
        for (int ks = 0; ks < 4; ++ks) oc = mfma16(LF16(Ss, 16 * et + fr, 32 * ks + 8 * fq), qf[ks], oc);
        o[et] = o[et] + wq * oc; s1 += sum4(o[et]); }
    s1 += __shfl_xor(s1, 16); s1 += __shfl_xor(s1, 32); const float mean = s1 * (1.0f / 128.0f); float s2 = 0.f;
#pragma unroll
    for (int et = 0; et < 8; ++et) { o[et] = o[et] - mean; s2 += sumsq4(o[et]); }
    s2 += __shfl_xor(s2, 16); s2 += __shfl_xor(s2, 32);
    const float sc = 1.0f / sqrtf(s2 * (1.0f / 128.0f) + EPS);
    const float* wnp = retw + h * 128 + 4 * fq;
#pragma unroll
    for (int et = 0; et < 8; ++et) { const f32x4 wn = *(const f32x4*)(wnp + 16 * et);
        u32x2 ov; ov.x = pk2(o[et][0] * sc * wn[0] * siluf_(bflo(gv[et].x)), o[et][1] * sc * wn[1] * siluf_(bfhi(gv[et].x))); ov.y = pk2(o[et][2] * sc * wn[2] * siluf_(bflo(gv[et].y)), o[et][3] * sc * wn[3] * siluf_(bfhi(gv[et].y)));
        *(u32x2*)(ws + moff + 32 * et) = ov; }
    __syncthreads();
}

#define XB_TMO      128
#define XB_XCNT(j)  (256  + 64 * (j))
#define XB_XSUB(j)  (1280 + 64 * (j))
#define XB_XGEN(j)  (2304 + 64 * (j))
#define XB_TOP      3328
#define XB_TOPGEN   3392
#define XCD_BAR_WORDS 3456
#define XB_SPIN_CAP (1u << 18)

__device__ __forceinline__ unsigned xb_ld(unsigned* p)              { return __hip_atomic_load(p, __ATOMIC_RELAXED, __HIP_MEMORY_SCOPE_AGENT); }
__device__ __forceinline__ unsigned xb_add(unsigned* p, unsigned v) { return __hip_atomic_fetch_add(p, v, __ATOMIC_RELAXED, __HIP_MEMORY_SCOPE_AGENT); }
__device__ __forceinline__ unsigned xb_xcc_id() { return (unsigned)__builtin_amdgcn_s_getreg((3 << 11) | 20) & 0xFu; }
#define XB_SPIN(cond, bar) do { unsigned _sp = 0; while (cond) { __builtin_amdgcn_s_sleep(1); \
    if ((++_sp & 255u) == 0u) { if (xb_ld(&(bar)[XB_TMO])) break; if (_sp > XB_SPIN_CAP) { atomicAdd(&(bar)[XB_TMO], 1u); break; } } } } while (0)

struct XcdBarrier {
    unsigned* bar; unsigned x;
    volatile LAS unsigned* st;
};

__device__ __forceinline__ XcdBarrier xcd_barrier_post(unsigned* bar, volatile LAS unsigned* st) {
    XcdBarrier b; b.bar = bar; b.x = xb_xcc_id(); b.st = st;
    if (threadIdx.x == 0) (void)xb_add(&bar[XB_XCNT(b.x)], 1u);
    return b;
}
__device__ __forceinline__ void xcd_barrier_complete(unsigned* bar, unsigned x, unsigned& nloc, unsigned& nx) {
    const unsigned G = gridDim.x * gridDim.y * gridDim.z;
    unsigned sum, cnt, mine, sp = 0u;
    for (;;) {
        sum = 0u; cnt = 0u; mine = 0u;
#pragma unroll
        for (unsigned j = 0; j < 16; ++j) { const unsigned c = xb_ld(&bar[XB_XCNT(j)]); sum += c; cnt += (c > 0u) ? 1u : 0u; mine = (j == x) ? c : mine; }
        if (sum == G) break;
        __builtin_amdgcn_s_sleep(1);
        if ((++sp & 255u) == 0u) { if (xb_ld(&bar[XB_TMO])) break; if (sp > XB_SPIN_CAP) { atomicAdd(&bar[XB_TMO], 1u); break; } }
    }
    nloc = mine > 0u ? mine : 1u; nx = cnt > 0u ? cnt : 1u;
}

__device__ __forceinline__ void xcd_barrier(const XcdBarrier& b) {
    asm volatile("s_waitcnt vmcnt(0)" ::: "memory");
    __syncthreads();
    if (threadIdx.x == 0) {
        unsigned* bar = b.bar;
        __builtin_amdgcn_s_waitcnt(0);
        unsigned nloc = b.st[0], nx = b.st[1];
        if (nloc == 0u) { xcd_barrier_complete(bar, b.x, nloc, nx); b.st[0] = nloc; b.st[1] = nx; }
        const unsigned old = xb_add(&bar[XB_XSUB(b.x)], 1u);
        const unsigned gen = old / nloc;
        if (old + 1u == (gen + 1u) * nloc) {
            __builtin_amdgcn_fence(__ATOMIC_RELEASE, "agent");
            asm volatile("s_waitcnt vmcnt(0)" ::: "memory");
            const unsigned og = xb_add(&bar[XB_TOP], 1u);
            const unsigned tg = og / nx;
            if (og + 1u == (tg + 1u) * nx) xb_add(&bar[XB_TOPGEN], 1u);
            else XB_SPIN(xb_ld(&bar[XB_TOPGEN]) == tg, bar);
            __builtin_amdgcn_fence(__ATOMIC_ACQUIRE, "agent");
            xb_add(&bar[XB_XGEN(b.x)], 1u);
            asm volatile("s_waitcnt vmcnt(0)" ::: "memory");
        } else {
            XB_SPIN(xb_ld(&bar[XB_XGEN(b.x)]) == gen, bar);
            __builtin_amdgcn_fence(__ATOMIC_ACQUIRE, "agent");
            asm volatile("s_waitcnt vmcnt(0)" ::: "memory");
        }
    }
    __syncthreads();
}


#define GEMM_PHASE(EpiT, SchedT, g, S, E) pg8::gemm_phase<EpiT, SchedT, true, true>((PG8_LAS unsigned char*)lds, g, S, E)

__global__ void __launch_bounds__(NTHR, 2) hymba_fwd(Args args) {
    extern __shared__ __attribute__((aligned(16))) unsigned char lds_raw[];
    LAS unsigned char* lds = (LAS unsigned char*)lds_raw;
    cg::grid_group grid = cg::this_grid();
    const int tid = threadIdx.x, lane = tid & 63, wave = __builtin_amdgcn_readfirstlane(tid >> 6);
    const int G = gridDim.x, bx = blockIdx.x, vcu = (G % 8 == 0) ? (bx % 8) * (G / 8) + bx / 8 : bx;
    const int gw = vcu * NWAVES + wave, NGW = G * NWAVES, swid = wave * G + vcu;
    const int gtid = vcu * NTHR + tid, NTH = G * NTHR;
    volatile LAS unsigned* xst = (volatile LAS unsigned*)(lds + LDS_BYTES - 16);
    if (tid == 0) { xst[0] = 0u; xst[1] = 0u; }
    __syncthreads();
    XcdBarrier xbar = xcd_barrier_post((unsigned*)(args.ws + WS_BAR), xst);
#ifndef PROBE_A
#define PROBE_A -1
#define PROBE_B -1
#endif
#ifndef PROBE_BX
#define PROBE_BX 0
#endif
    LAS unsigned long long* TS = (LAS unsigned long long*)(lds + LDS_BYTES - 160);
#define STAMP(i) do { if (PROBE_A >= 0 && bx == PROBE_BX && tid == 0) TS[i] = __builtin_amdgcn_s_memrealtime(); } while (0)
    STAMP(0);
    typedef const __attribute__((address_space(4))) Args* KArgP;
#define KA() ({ KArgP _k = (KArgP)__builtin_amdgcn_kernarg_segment_ptr(); asm volatile("" : "+s"(_k)); _k; })
    const int lo = args.ph_lo, hi = args.ph_hi;
#ifndef PHASE_MASK
#define PHASE_MASK 0xffff
#endif
#define IN(k) (((PHASE_MASK >> (k)) & 1) && lo <= (k) && (k) < hi)
#ifndef REP_MASK
#define REP_MASK 0
#endif
#ifndef SYNC_REP
#define SYNC_REP 1
#endif
#define NREP(k) ((((REP_MASK) >> (k)) & 1) ? 2 : 1)
#define SEAM(k) do { if (IN(k) && IN((k) + 1)) { for (int sr = 0; sr < SYNC_REP; ++sr) { if ((k) == 0) grid.sync(); else xcd_barrier(xbar); } } } while (0)
#define SSQ1 ((float*)(ws + WS_SSQ1))
#define SSQ2 ((float*)(ws + WS_SSQ2))
#define SSQ3 ((float*)(ws + WS_SSQ3))
#define SSQG ((float*)(ws + WS_SSQG))
#define N1M ((bf16*)(ws + WS_N1M))
#define GUM ((float*)(ws + WS_GUM))
#define H1MF ((float*)(ws + WS_H1MF))
#define PM ((float*)(ws + WS_PM))
#define ST0 ((float*)(ws + WS_ST0))
#define ZM ((float*)(ws + WS_ZM))
#define A16 ((const f32x2*)(ws + WS_A16))
#define H1B ((bf16*)(ws + WS_H1B))
#define WMAIN ((bf16*)(ws + WS_WMAIN))
#define WKV ((bf16*)(ws + WS_WKV))
#define ROT ((f32x2*)(ws + WS_ROT))
#define ACT ((bf16*)(ws + WS_ACT))
#define Qb ((bf16*)(ws + WS_Q))
#define Kb ((bf16*)(ws + WS_K))
#define Gb ((bf16*)(ws + WS_G))
#define KWT ((bf16*)(ws + WS_KWT))
#define VT ((bf16*)(ws + WS_VT))
#define N1 ((bf16*)(ws + WS_N1))
#define UA ((bf16*)(ws + WS_UA))
#define MIX ((bf16*)(ws + WS_MIX))
#define Zb ((float*)(ws + WS_Z))
#define SPT ((bf16*)(ws + WS_SPT))
#define KVT ((float*)(ws + WS_KVT))
#define Yb ((bf16*)(ws + WS_Y))

    if (IN(0)) for (int rep = 0; rep < NREP(0); ++rep) {
        if (rep) __syncthreads();
        Args a0; { KArgP ka = KA(); for (int i = 0; i < 26; ++i) a0.in[i] = ka->in[i]; a0.out = ka->out; a0.ws = ka->ws; a0.ph_lo = 0; a0.ph_hi = 0; } const Args& args = a0; unsigned char* ws = a0.ws;
        for (int g = vcu; g < 32; g += G) ssm_mats(args, g, lds, tid);
        LAS float* scr = (LAS float*)(lds + wave * 17408);
        {
            const bool split = (G > 32); const bool worker = !split || vcu >= 32;
            const int ww = split ? gw - 32 * NWAVES : gw, WW = split ? NGW - 32 * NWAVES : NGW;
            const int wt = split ? gtid - 32 * NTHR : gtid, WTN = split ? NTH - 32 * NTHR : NTH;
            if (worker) {
                tr_run(args, 0, 12, ww, WW, scr, lane);
                for (int m = ww; m < NT; m += 4 * WW) {
                    if (m + 3 * WW < NT) rms_rows4_to_bf16(args.in[0] + (size_t)m * DM, (size_t)WW * DM, args.in[2], N1 + (size_t)m * DM, (size_t)WW * DM, lane);
                    else for (int q = 0; q < 4; ++q) if (m + q * WW < NT) rms_row_to_bf16(args.in[0] + (size_t)(m + q * WW) * DM, args.in[2], N1 + (size_t)(m + q * WW) * DM, lane);
                }
                if (ww < 16) rms_row_to_bf16(args.in[1] + (size_t)ww * DM, args.in[2], N1M + (size_t)ww * DM, lane);
                {   const int i = wt & 63; const double f = exp2(-(double)i * (13.287712379549449 / 64.0));
                    for (int idx = wt; idx < 8208 * 64; idx += WTN) { const int pos = idx >> 6; double ang = (double)pos * f; ang -= 6.283185307179586 * floor(ang * 0.15915494309189535);
                        float sn, cs; sincosf((float)ang, &sn, &cs); ROT[idx] = (f32x2){cs, sn}; } }
                for (int idx = wt; idx < NT; idx += WTN) { SSQ1[idx] = 0.f; SSQ2[idx] = 0.f; SSQ3[idx] = 0.f; SSQG[idx] = 0.f; }
                for (int idx = wt; idx < 16 * 1024; idx += WTN) H1MF[idx] = args.in[1][idx];
                for (int idx = wt; idx < 16 * 1536; idx += WTN) PM[idx] = 0.f;
            }
        }
    }
    STAMP(13);
    SEAM(0);
    STAMP(1);
    if (IN(1)) for (int rep = 0; rep < NREP(1); ++rep) {
        if (rep) __syncthreads();
        KArgP ka = KA(); unsigned char* ws = ka->ws;
        if (bx >= G / 2) skinny((const bf16*)(ws + WS_WGU1), DM, 352, 1, DM, wave * (G - G / 2) + (bx - G / 2), NWAVES * (G - G / 2), ALBf16{N1M, DM}, EPStore{GUM, 5632}, lane);
        pg8::Gemm g{N1, (const bf16*)(ws + WS_WGU1), DM, DM, DM}; pg8::StaticOrder S; S.init(NT, 5632, G, bx);
        EpiSwiGLU E{ACT, nullptr};
        GEMM_PHASE(EpiSwiGLU, pg8::StaticOrder, g, S, E);
    }
    SEAM(1);
    STAMP(2);
    if (IN(2)) for (int rep = 0; rep < NREP(2); ++rep) {
        if (rep) __syncthreads();
        KArgP ka = KA(); unsigned char* ws = ka->ws;
        skinny((const bf16*)(ws + WS_WD1), FF, 64, 22, FF, swid, NGW, ALSwiGLU{GUM}, EPAtomic{H1MF, 1024, 0.5f}, lane);
        pg8::Gemm g{ACT, (const bf16*)(ws + WS_WD1), FF, FF, FF}; pg8::StaticOrder S; S.init(NT, DM, G, bx);
        EpiRes<0> E{ka->in[0], ka->out, H1B, SSQ1, nullptr};
        GEMM_PHASE(EpiRes<0>, pg8::StaticOrder, g, S, E);
    }
    SEAM(2);
    STAMP(3);
    if (IN(3)) for (int rep = 0; rep < NREP(3); ++rep) {
        if (rep) __syncthreads();
        KArgP ka = KA(); unsigned char* ws = ka->ws;
        skinny(WMAIN + (size_t)512 * DM, DM, 32, 8, DM, swid, NGW, ALF32{H1MF, DM}, EPAtomic{PM, 1536, 1.0f}, lane);
        skinny(WKV + (size_t)512 * DM, DM, 32, 8, DM, (swid + NGW - 256) % NGW, NGW, ALF32{H1MF, DM}, EPAtomic{PM + 512, 1536, 1.0f}, lane);
        skinny(WMAIN + (size_t)1536 * DM, DM, 32, 8, DM, (swid + NGW - 512) % NGW, NGW, ALF32{H1MF, DM}, EPAtomic{PM + 1024, 1536, 1.0f}, lane);
        pg8::Gemm g{H1B, WMAIN, DM, DM, DM}; P3Order S{G, vcu};
        EpiInProj E{SSQ1, ROT, Qb, Kb, Gb, UA, KWT, VT};
        GEMM_PHASE(EpiInProj, P3Order, g, S, E);
    }
    SEAM(3);
    STAMP(4);
    if (IN(4)) for (int rep = 0; rep < NREP(4); ++rep) {
        if (rep) __syncthreads();
        KArgP ka = KA(); unsigned char* ws = ka->ws;
        const int nhalf = G / 2;
        if (vcu >= nhalf) {
            LAS float* rs1 = (LAS float*)lds;
            for (int r = wave * 2; r < wave * 2 + 2; ++r) { float s = 0.f; for (int c = lane; c < DM; c += 64) { const float v = H1MF[r * DM + c]; s += v * v; } s = wave_sum(s); if (lane == 0) rs1[r] = 1.0f / sqrtf(s * (1.0f / 1024.0f) + EPS); }
            __syncthreads();
            const int sb = vcu - nhalf, nsb = G - nhalf;
            for (int o = sb * NTHR + tid; o < 65536; o += nsb * NTHR) { const int h = o >> 14, e = (o >> 7) & 127, d = o & 127, i = d & 63; const float l2g = log2gamma(h); float acc = 0.f;
#pragma unroll
                for (int j = 0; j < 16; ++j) { const float r = rs1[j]; const float x1 = PM[j * 1536 + 256 * (h >> 1) + 64 * (h & 1) + i], x2 = PM[j * 1536 + 256 * (h >> 1) + 64 * (h & 1) + i + 128]; const f32x2 cs = ROT[j * 64 + i];
                    const float kd = (d < 64) ? (x1 * cs.x - x2 * cs.y) : (x1 * cs.y + x2 * cs.x); acc += exp2f(l2g * (float)(15 - j)) * kd * PM[j * 1536 + 512 + h * 128 + e] * (r * r * 0.08838834764831845f); }
                ST0[o] = acc; }
            for (int o = sb * NWAVES + wave; o < 4096; o += nsb * NWAVES) {
                const int g = o >> 7, r = o & 127; const bf16* wz = (const bf16*)(ws + WS_WZ) + (size_t)(g * 256 + r) * 256; float acc = 0.f;
#pragma unroll
                for (int k = 0; k < 4; ++k) { const int c = lane + 64 * k; acc += bf2f(wz[c]) * PM[(c >> 4) * 1536 + 1024 + g * 16 + (c & 15)] * rs1[c >> 4]; }
                acc = wave_sum(acc); if (lane == 0) ZM[o] = acc; }
            __syncthreads();
        }
        if (G == 256) { if (vcu >= 128) { for (int k2 = 0; k2 < 3; ++k2) r1_item_lds((vcu - 128) + 128 * k2, ws, lds, wave, lane, tid); } else r1_item_lds(384 + vcu, ws, lds, wave, lane, tid); }
        else for (int it = vcu; it < 512; it += G) r1_item_lds(it, ws, lds, wave, lane, tid);
        __syncthreads();
        int kdyn = 256; asm volatile("" : "+s"(kdyn)); pg8::Gemm g{UA, (const bf16*)(ws + WS_WZ), kdyn, 384, 256}; GroupOrder S{G, vcu};
        EpiZ E{Zb};
        GEMM_PHASE(EpiZ, GroupOrder, g, S, E);
    }
    SEAM(4);
    STAMP(5);
    if (IN(6)) for (int rep = 0; rep < NREP(6); ++rep) {
        if (rep) __syncthreads();
        KArgP ka = KA(); unsigned char* ws = ka->ws;
        if (rep == 0) {
        for (int L = vcu; L < 128; L += G) {
            const int g = L >> 2, rt = L & 3, b = rt >> 1, half = rt & 1, n = lane; const f32x2 a16 = A16[g * 64 + n];
            LAS f32x2* T = (LAS f32x2*)lds;
            const float* zb = Zb + ((size_t)g * 1024 + b * 512) * 128 + n;
            float zr[32], zi[32];
            for (int sg = wave; sg < 8 + 8 * half; sg += 8) { f32x2 X = (f32x2){0.f, 0.f};
#pragma unroll
                for (int c = 0; c < 32; ++c) { zr[c] = zb[(size_t)(sg * 32 + c) * 128]; zi[c] = zb[(size_t)(sg * 32 + c) * 128 + 64]; }
#pragma unroll
                for (int c = 0; c < 32; ++c) { const f32x2 t = cmul(a16, X); X = (f32x2){t.x + zr[c], t.y + zi[c]}; }
                T[sg * 64 + n] = X; }
            __syncthreads();
            f32x2 a512 = a16;
#pragma unroll
            for (int q = 0; q < 5; ++q) a512 = cmul(a512, a512);
            { const int sg = half * 8 + wave; f32x2 X = (f32x2){ZM[g * 128 + n], ZM[g * 128 + 64 + n]};
                for (int s2 = 0; s2 < sg; ++s2) { const f32x2 t = cmul(a512, X), tt = T[s2 * 64 + n]; X = (f32x2){t.x + tt.x, t.y + tt.y}; }
                bf16* xo = UA + ((size_t)g * 1024 + b * 512 + sg * 32) * 384 + 256 + n;
                {
#pragma unroll
                    for (int c = 0; c < 32; ++c) { xo[(size_t)c * 384] = (bf16)(pk2(X.x, 0.f) & 0xffffu); xo[(size_t)c * 384 + 64] = (bf16)(pk2(X.y, 0.f) & 0xffffu);
                        const f32x2 t = cmul(a16, X); X = (f32x2){t.x + zr[c], t.y + zi[c]}; } } }
            asm volatile("s_waitcnt vmcnt(0)" ::: "memory");
            __syncthreads();
        }
        {
            const bool all = (G <= 128); const int t0 = all ? gtid : gtid - 128 * NTHR, tn = all ? NTH : NTH - 128 * NTHR;
            if (all || vcu >= 128)
            for (int idx = t0; idx < 8 * 16384; idx += tn) { const int bh = idx >> 14, ed = idx & 16383, h = bh & 3; const float gch = exp2f(128.0f * log2gamma(h)); float S = ST0[h * 16384 + ed];
                const float* kv = KVT + (size_t)bh * 64 * 16384 + ed; bf16* sp = SPT + (size_t)bh * 64 * 16384 + ed;
                { float v[64];
#pragma unroll
                    for (int c = 0; c < 64; ++c) v[c] = kv[(size_t)c * 16384];
#pragma unroll
                    for (int c = 0; c < 64; ++c) { sp[(size_t)c * 16384] = (bf16)(pk2(S, 0.f) & 0xffffu); S = gch * S + v[c]; } } }
        }
        }
        STAMP(14);
        if (rep == 0) {
            Args a0; { for (int i = 0; i < 26; ++i) a0.in[i] = ka->in[i]; a0.out = nullptr; a0.ws = ws; a0.ph_lo = 0; a0.ph_hi = 0; }
            LAS float* scr = (LAS float*)(lds + wave * 17408); const int tw0 = gw, tnw = NGW;
            if (G == 256) {
                constexpr int NSPLIT = 1890;
                if (vcu >= 128) tr_run(a0, 12, NJOBS, gw - 128 * NWAVES, 128 * NWAVES, scr, lane, NSPLIT);
                else tr_run(a0, 12, NJOBS, NSPLIT + gw, 128 * NWAVES, scr, lane);
            } else tr_run(a0, 12, NJOBS, tw0, tnw, scr, lane);
            __syncthreads();
        }
        STAMP(15);
        int kdyn = 384; asm volatile("" : "+s"(kdyn)); pg8::Gemm g{UA, (const bf16*)(ws + WS_WY), kdyn, 384, 384}; GroupOrder S{G, vcu};
        EpiY E{UA, ka->in[16], Yb};
        GEMM_PHASE(EpiY, GroupOrder, g, S, E);
    }
    SEAM(6);
    STAMP(7);
    if (IN(7)) for (int rep = 0; rep < NREP(7); ++rep) {
        if (rep) __syncthreads();
        KArgP ka = KA(); unsigned char* ws = ka->ws;
        if (rep == 0) {
            R3Regs R;
            if (G == 256) {
                if (bx >= 128) { const int i0 = bx - 128; r3_loads(i0, ws, R, tid);
                    r3_item_pipe(i0, i0 + 128, R, ws, ka->in[8], lds, wave, lane, tid); r3_item_pipe(i0 + 128, i0 + 256, R, ws, ka->in[8], lds, wave, lane, tid); r3_item_pipe(i0 + 256, -1, R, ws, ka->in[8], lds, wave, lane, tid); }
                else { r3_loads(384 + bx, ws, R, tid); r3_item_pipe(384 + bx, -1, R, ws, ka->in[8], lds, wave, lane, tid); }
            } else for (int it = vcu; it < 512; it += G) { r3_loads(it, ws, R, tid); r3_item_pipe(it, -1, R, ws, ka->in[8], lds, wave, lane, tid); }
        }
        pg8::Gemm g{Yb, (const bf16*)(ws + WS_WGLU), 512, 512, 512}; pg8::StaticOrder S; S.init(NT, 512, G, bx);
        EpiGLU E{Yb, ka->in[18], MIX, SSQG};
        GEMM_PHASE(EpiGLU, pg8::StaticOrder, g, S, E);
    }
    SEAM(8);
    STAMP(9);
    if (IN(9)) for (int rep = 0; rep < NREP(9); ++rep) {
        if (rep) __syncthreads();
        KArgP ka = KA(); unsigned char* ws = ka->ws; float* outp = ka->out;
        pg8::Gemm g{MIX, (const bf16*)(ws + WS_WOUT), DM, DM, DM}; pg8::StaticOrder S; S.init(NT, DM, G, bx);
        EpiRes<1> E{outp, outp, H1B, SSQ2, SSQG};
        GEMM_PHASE(EpiRes<1>, pg8::StaticOrder, g, S, E);
    }
    SEAM(9);
    STAMP(10);
    if (IN(10)) for (int rep = 0; rep < NREP(10); ++rep) {
        if (rep) __syncthreads();
        KArgP ka = KA(); unsigned char* ws = ka->ws;
        pg8::Gemm g{H1B, (const bf16*)(ws + WS_WGU2), DM, DM, DM}; pg8::StaticOrder S; S.init(NT, 5632, G, bx);
        EpiSwiGLU E{ACT, SSQ2};
        GEMM_PHASE(EpiSwiGLU, pg8::StaticOrder, g, S, E);
    }
    SEAM(10);
    STAMP(11);
    if (IN(11)) for (int rep = 0; rep < NREP(11); ++rep) {
        if (rep) __syncthreads();
        KArgP ka = KA(); unsigned char* ws = ka->ws; float* outp = ka->out;
        pg8::Gemm g{ACT, (const bf16*)(ws + WS_WD2), FF, FF, FF}; pg8::StaticOrder S; S.init(NT, DM, G, bx);
        EpiFinal E{outp, outp, SSQ3, (unsigned*)(ws + WS_BAR + 16 * KiB), ka->in[25]};
        GEMM_PHASE(EpiFinal, pg8::StaticOrder, g, S, E);
    }
    STAMP(12);
    if (PROBE_A >= 0 && bx == PROBE_BX && tid == 0) {
        const unsigned long long d = TS[PROBE_B] - TS[PROBE_A], t0 = __builtin_amdgcn_s_memrealtime();
        while (__builtin_amdgcn_s_memrealtime() - t0 < 4ull * d) __builtin_amdgcn_s_sleep(8);
    }
#undef IN
#undef SEAM
}

#ifndef MK_PER_PHASE
#define MK_PER_PHASE 0
#endif
constexpr int NPHASES = 13;
extern "C" void kernel_launch(void* const* d_in, const int* in_sizes, int n_in, void* d_out, int out_size, void* d_ws, size_t ws_size, hipStream_t stream) {
    static int grid = 0;
    if (grid == 0) {
        if (n_in != 26 || out_size != NT * DM || ws_size < WS_END) { fprintf(stderr, "kernel_launch: unexpected shapes (n_in %d, out %d, ws %zu)\n", n_in, out_size, ws_size); grid = -1; return; }
        int dev = 0, cus = 0, per_cu = 0;
        hipGetDevice(&dev); hipDeviceGetAttribute(&cus, hipDeviceAttributeMultiprocessorCount, dev);
        if (hipFuncSetAttribute((const void*)hymba_fwd, hipFuncAttributeMaxDynamicSharedMemorySize, LDS_BYTES) != hipSuccess) { fprintf(stderr, "kernel_launch: hipFuncSetAttribute failed\n"); grid = -1; return; }
        if (hipOccupancyMaxActiveBlocksPerMultiprocessor(&per_cu, (const void*)hymba_fwd, NTHR, LDS_BYTES) != hipSuccess || per_cu < 1) { fprintf(stderr, "kernel_launch: occupancy query failed (%d)\n", per_cu); (void)hipGetLastError(); per_cu = 1; }
        grid = cus * 1;
        fprintf(stderr, "kernel_launch: grid %d (per_cu %d), ws %zu\n", grid, per_cu, ws_size);
    }
    if (grid < 0) return;
    Args a{};
    for (int i = 0; i < 26; ++i) a.in[i] = (const float*)d_in[i];
    a.out = (float*)d_out; a.ws = (unsigned char*)d_ws;
    if (hipMemsetAsync((char*)d_ws + WS_BAR, 0, BAR_BYTES, stream) != hipSuccess) { fprintf(stderr, "kernel_launch: memset of barrier words failed\n"); return; }
#if MK_PER_PHASE
    for (int p = 0; p < NPHASES; ++p) { a.ph_lo = p; a.ph_hi = p + 1; hipLaunchKernelGGL(hymba_fwd, dim3(grid), dim3(NTHR), LDS_BYTES, stream, a); }
#else
    a.ph_lo = 0; a.ph_hi = NPHASES;
    void* kargs[] = {&a};
    hipError_t e = hipLaunchCooperativeKernel((const void*)hymba_fwd, dim3(grid), dim3(NTHR), kargs, LDS_BYTES, stream);
    if (e != hipSuccess) fprintf(stderr, "kernel_launch: cooperative launch failed: %s (grid %d)\n", hipGetErrorString(e), grid);
#endif
}
```

```cpp
#include <hip/hip_runtime.h>
#include <hip/hip_cooperative_groups.h>
#include <cstdio>
#include <cstdint>
namespace cg = cooperative_groups;
namespace pg8 {
#define PG8_LAS __attribute__((address_space(3)))
typedef unsigned short bf16_t;
typedef short bf16x8 __attribute__((ext_vector_type(8)));
typedef float f32x4 __attribute__((ext_vector_type(4)));
typedef unsigned u32x4 __attribute__((ext_vector_type(4)));
constexpr int BM = 256, BK = 64, HALF = 128, HTB = HALF * BK * 2  , STAGE_BYTES = 8 * HTB, NXCD = 8, WGM = 8;

__host__ __device__ __forceinline__ int lds_byte(int r, int c) { const int st = (r >> 4) * 2 + (c >> 5), rr = r & 15, cc = c & 31, ob = rr * 64 + cc * 2; return st * 1024 + (ob ^ (((ob >> 9) & 1) << 5)); }
__host__ __device__ __forceinline__ void stage_rc(int b, int& R, int& C) { const int st = b / 1024, sb = b % 1024, swz = sb ^ (((sb >> 9) & 1) << 5); R = (st >> 1) * 16 + swz / 64; C = (st & 1) * 32 + (swz % 64) / 2; }
__host__ __device__ __forceinline__ int perm32(int rho) { const int n = rho >> 4, i = rho & 15; return 8 * (i >> 2) + 4 * n + (i & 3); }

struct Unit { int pm, pn; };
struct Gemm { const bf16_t* A; const bf16_t* Bt; int K, lda, ldb; };

struct StaticOrder {
    int nM, nN, nwg, G, c;
    __host__ __device__ void init(int M, int N, int G_, int c_) { nM = M / BM; nN = N / BM; nwg = nM * nN; G = G_; c = c_; }
    __host__ __device__ bool next(int i, Unit& u) const {
        const long L = (long)i * G + c; if (L >= nwg) return false;
        int wgid = (int)L; { const int q = nwg / NXCD, r = nwg % NXCD, xcd = wgid % NXCD, off = wgid / NXCD; wgid = (xcd < r ? xcd * (q + 1) : r * (q + 1) + (xcd - r) * q) + off; }
        const int nig = WGM * nN, gid = wgid / nig, fm = gid * WGM, gsz = (nM - fm) < WGM ? (nM - fm) : WGM;
        u.pm = fm + ((wgid % nig) % gsz); u.pn = (wgid % nig) / gsz; return true;
    }
    __device__ __forceinline__ void a_ready(const Unit&) const {}
    __device__ __forceinline__ void done(const Unit&) const {}
};

__device__ __forceinline__ unsigned cvt_pk_bf16(float lo, float hi) { unsigned r; asm volatile("v_cvt_pk_bf16_f32 %0, %1, %2" : "=v"(r) : "v"(lo), "v"(hi)); return r; }
template <class Epi, class Sched, bool ALIGN_EPI = false, bool SP2 = false>
__device__ __forceinline__ void gemm_phase(PG8_LAS unsigned char* lds, const Gemm g, const Sched& S, const Epi& E) {
    const int tid = threadIdx.x, wid = __builtin_amdgcn_readfirstlane(tid >> 6), lane = tid & 63, wr = wid >> 2, wc = wid & 3, fr = lane & 15, fq = lane >> 4;
    const int K = g.K, nt = K / BK;
    unsigned voffA[2], voffB[2];
#pragma unroll
    for (int i = 0; i < 2; ++i) { int R, C; stage_rc(tid * 16 + i * 8192, R, C); const int Rb = Epi::PERM ? ((R & ~31) + perm32(R & 31)) : R;
        voffA[i] = (unsigned)(R * g.lda + C) * 2u; voffB[i] = (unsigned)(Rb * g.ldb + C) * 2u; }
    const size_t kstep = (size_t)(BK * 2);
    const size_t hstepA = (size_t)HALF * g.lda * 2, hstepB = (size_t)HALF * g.ldb * 2;
    const size_t tstepA = 2 * hstepA, tstepB = 2 * hstepB;
    const unsigned ldsw = (unsigned)wid * 1024u;
    const int aoff = lds_byte(wr * 64 + fr, fq * 8), boff = lds_byte(wc * 32 + fr, fq * 8);
#define PG8_SA(b, h) (((b) * 2 + (h)) * HTB)
#define PG8_SB(b, h) ((4 + (b) * 2 + (h)) * HTB)
#define PG8_STAGE(bufoff, gbase, voff) do { _Pragma("unroll") for (int _i = 0; _i < 2; ++_i) \
        __builtin_amdgcn_global_load_lds((const unsigned*)((const char*)(gbase) + (voff)[_i]), (PG8_LAS unsigned*)(lds + (bufoff) + ldsw + _i * 8192), 16, 0, 0); } while (0)
#define PG8_LDA(dst, b, h) do { _Pragma("unroll") for (int m = 0; m < 4; ++m) _Pragma("unroll") for (int k = 0; k < 2; ++k) dst[m][k] = *(const PG8_LAS bf16x8*)(lds + PG8_SA(b, h) + aoff + m * 2048 + k * 1024); } while (0)
#define PG8_LDB(dst, b, h) do { _Pragma("unroll") for (int n = 0; n < 2; ++n) _Pragma("unroll") for (int k = 0; k < 2; ++k) dst[n][k] = *(const PG8_LAS bf16x8*)(lds + PG8_SB(b, h) + boff + n * 2048 + k * 1024); } while (0)
#define PG8_MMA(ai, bj, At, Bt) do { __builtin_amdgcn_s_setprio(1); _Pragma("unroll") for (int m = 0; m < 4; ++m) _Pragma("unroll") for (int n = 0; n < 2; ++n) _Pragma("unroll") for (int k = 0; k < 2; ++k) \
        acc[ai][bj][m][n] = __builtin_amdgcn_mfma_f32_16x16x32_bf16(Bt[n][k], At[m][k], acc[ai][bj][m][n], 0, 0, 0); __builtin_amdgcn_s_setprio(0); } while (0)
#define PG8_WAIT_V(n) asm volatile("s_waitcnt vmcnt(" #n ")" ::: "memory")
#define PG8_WAIT_L(n) asm volatile("s_waitcnt lgkmcnt(" #n ")" ::: "memory")
#define PG8_BAR __builtin_amdgcn_s_barrier()
#define PG8_SCHED __builtin_amdgcn_sched_barrier(0)
    Unit cur, nxt; int ui = 0;
    if (!S.next(0, cur)) return;
    f32x4 acc[2][2][4][2];
#pragma unroll
    for (int a = 0; a < 2; ++a)
#pragma unroll
        for (int b = 0; b < 2; ++b)
#pragma unroll
            for (int m = 0; m < 4; ++m)
#pragma unroll
                for (int n = 0; n < 2; ++n) acc[a][b][m][n] = (f32x4){0.f, 0.f, 0.f, 0.f};
    bf16x8 At[4][2], B0[2][2], B1[2][2];
    const char* cA = (const char*)g.A + (size_t)cur.pm * tstepA; const char* cB = (const char*)g.Bt + (size_t)cur.pn * tstepB;
    S.a_ready(cur);
    if constexpr (SP2) {
        PG8_STAGE(PG8_SB(0, 0), cB, voffB); PG8_STAGE(PG8_SB(0, 1), cB + hstepB, voffB); PG8_STAGE(PG8_SA(0, 0), cA, voffA); PG8_STAGE(PG8_SA(0, 1), cA + hstepA, voffA);
        if (wr == 1) PG8_BAR;
        PG8_WAIT_V(2); PG8_BAR;
        PG8_STAGE(PG8_SB(1, 0), cB + kstep, voffB); PG8_STAGE(PG8_SA(1, 0), cA + kstep, voffA); PG8_STAGE(PG8_SB(1, 1), cB + hstepB + kstep, voffB);
        PG8_WAIT_V(6); PG8_BAR;
    } else {
        PG8_STAGE(PG8_SB(0, 0), cB, voffB); PG8_STAGE(PG8_SA(0, 0), cA, voffA); PG8_STAGE(PG8_SB(0, 1), cB + hstepB, voffB); PG8_STAGE(PG8_SA(0, 1), cA + hstepA, voffA);
        if (wr == 1) PG8_BAR;
        PG8_WAIT_V(4); PG8_BAR;
        PG8_STAGE(PG8_SB(1, 0), cB + kstep, voffB); PG8_STAGE(PG8_SA(1, 0), cA + kstep, voffA); PG8_STAGE(PG8_SB(1, 1), cB + hstepB + kstep, voffB);
        PG8_WAIT_V(6); PG8_BAR;
    }
    for (;;) {
        const bool has_next = S.next(ui + 1, nxt);
        const char* nA = has_next ? (const char*)g.A + (size_t)nxt.pm * tstepA : cA; const char* nB = has_next ? (const char*)g.Bt + (size_t)nxt.pn * tstepB : cB;
        for (int t = 0; t < nt; t += 2) {
            if constexpr (Epi::HAS_MID) { if (t == Epi::MID_T) E.mid(acc, cur, wr, fr); }
            const bool last = (t == nt - 2);
            const char* a1 = cA + (size_t)(t + 1) * kstep;
            const char* a2 = last ? nA : cA + (size_t)(t + 2) * kstep; const char* b2 = last ? nB : cB + (size_t)(t + 2) * kstep;
            const char* a3 = a2 + kstep; const char* b3 = b2 + kstep;
            if (last && has_next) S.a_ready(nxt);
            if constexpr (SP2) {
            PG8_LDB(B0, 0, 0); PG8_LDB(B1, 0, 1); PG8_SCHED; PG8_LDA(At, 0, 0); PG8_STAGE(PG8_SA(1, 1), a1 + hstepA, voffA);
            PG8_WAIT_V(8); PG8_WAIT_L(0); PG8_BAR; PG8_MMA(0, 0, At, B0); PG8_MMA(0, 1, At, B1); PG8_BAR; PG8_SCHED;
            PG8_LDA(At, 0, 1); PG8_STAGE(PG8_SB(0, 0), b2, voffB); PG8_STAGE(PG8_SB(0, 1), b2 + hstepB, voffB); PG8_STAGE(PG8_SA(0, 0), a2, voffA);
            PG8_WAIT_V(8); PG8_WAIT_L(0); PG8_BAR; PG8_MMA(1, 0, At, B0); PG8_MMA(1, 1, At, B1); PG8_BAR; PG8_SCHED;
            PG8_LDB(B0, 1, 0); PG8_LDB(B1, 1, 1); PG8_SCHED; PG8_LDA(At, 1, 0); PG8_STAGE(PG8_SA(0, 1), a2 + hstepA, voffA);
            PG8_WAIT_V(8); PG8_WAIT_L(0); PG8_BAR; PG8_MMA(0, 0, At, B0); PG8_MMA(0, 1, At, B1); PG8_BAR; PG8_SCHED;
            PG8_LDA(At, 1, 1); PG8_STAGE(PG8_SB(1, 0), b3, voffB); PG8_STAGE(PG8_SB(1, 1), b3 + hstepB, voffB); PG8_STAGE(PG8_SA(1, 0), a3, voffA);
            PG8_WAIT_V(8); PG8_WAIT_L(0); PG8_BAR; PG8_MMA(1, 0, At, B0); PG8_MMA(1, 1, At, B1); PG8_BAR; PG8_SCHED;
            } else {
            PG8_LDB(B0, 0, 0); PG8_SCHED; PG8_LDA(At, 0, 0); PG8_STAGE(PG8_SA(1, 1), a1 + hstepA, voffA);
            PG8_WAIT_L(8); PG8_BAR; PG8_WAIT_L(0); PG8_MMA(0, 0, At, B0); PG8_BAR; PG8_SCHED;
            PG8_LDB(B1, 0, 1); PG8_STAGE(PG8_SB(0, 0), b2, voffB);
            PG8_BAR; PG8_WAIT_L(0); PG8_MMA(0, 1, At, B1); PG8_BAR;
            PG8_LDA(At, 0, 1); PG8_STAGE(PG8_SA(0, 0), a2, voffA);
            PG8_BAR; PG8_WAIT_L(0); PG8_MMA(1, 0, At, B0); PG8_BAR; PG8_SCHED;
            PG8_STAGE(PG8_SB(0, 1), b2 + hstepB, voffB);
            PG8_WAIT_V(6); PG8_BAR; PG8_MMA(1, 1, At, B1); PG8_BAR;
            PG8_LDB(B0, 1, 0); PG8_SCHED; PG8_LDA(At, 1, 0); PG8_STAGE(PG8_SA(0, 1), a2 + hstepA, voffA);
            PG8_WAIT_L(8); PG8_BAR; PG8_WAIT_L(0); PG8_MMA(0, 0, At, B0); PG8_BAR; PG8_SCHED;
            PG8_LDB(B1, 1, 1); PG8_STAGE(PG8_SB(1, 0), b3, voffB);
            PG8_BAR; PG8_WAIT_L(0); PG8_MMA(0, 1, At, B1); PG8_BAR;
            PG8_LDA(At, 1, 1); PG8_STAGE(PG8_SA(1, 0), a3, voffA);
            PG8_BAR; PG8_WAIT_L(0); PG8_MMA(1, 0, At, B0); PG8_BAR; PG8_SCHED;
            PG8_STAGE(PG8_SB(1, 1), b3 + hstepB, voffB);
            PG8_WAIT_V(6); PG8_BAR; PG8_MMA(1, 1, At, B1); PG8_BAR;
            }
        }
        if constexpr (ALIGN_EPI) { if (wr == 0) PG8_BAR; }
        if constexpr (!Epi::AFTER_DRAIN) { E(acc, cur, wr, wc, fr, fq); S.done(cur); }
        if (!has_next) break;
#pragma unroll
        for (int a = 0; a < 2; ++a)
#pragma unroll
            for (int b = 0; b < 2; ++b)
#pragma unroll
                for (int m = 0; m < 4; ++m)
#pragma unroll
                    for (int n = 0; n < 2; ++n) acc[a][b][m][n] = (f32x4){0.f, 0.f, 0.f, 0.f};
        cur = nxt; cA = nA; cB = nB; ++ui;
        if constexpr (ALIGN_EPI) { if (wr == 1) PG8_BAR; }
    }
    PG8_WAIT_V(0);
    if constexpr (!ALIGN_EPI) { if (wr == 0) PG8_BAR; }
    PG8_BAR;
    if constexpr (Epi::AFTER_DRAIN) { E.fused(acc, cur, wr, wc, fr, fq, lds, wid, lane); S.done(cur); }
#undef PG8_SA
#undef PG8_SB
#undef PG8_STAGE
#undef PG8_LDA
#undef PG8_LDB
#undef PG8_MMA
#undef PG8_WAIT_V
#undef PG8_WAIT_L
#undef PG8_BAR
#undef PG8_SCHED
}
}

#define LAS __attribute__((address_space(3)))
typedef unsigned short bf16;
typedef float f32x4 __attribute__((ext_vector_type(4)));
typedef float f32x2 __attribute__((ext_vector_type(2)));
typedef short bf16x8 __attribute__((ext_vector_type(8)));
typedef short bf16x4 __attribute__((ext_vector_type(4)));
typedef unsigned u32x4 __attribute__((ext_vector_type(4)));
typedef unsigned u32x2 __attribute__((ext_vector_type(2)));
using pg8::Unit;

constexpr int NWAVES = 8, NTHR = 512;
constexpr int NT = 16384, DM = 1024, FF = 2816;
constexpr float EPS = 1e-6f;
constexpr int LDS_BYTES = 147456;
constexpr size_t MiB = 1u << 20, KiB = 1024;
constexpr size_t WS_SSQ1 = 0, WS_SSQ2 = 1 * MiB, WS_SSQ3 = 2 * MiB, WS_SSQG = 3 * MiB;
constexpr size_t WS_BAR = 5 * MiB, BAR_BYTES = 32 * KiB;
constexpr size_t WS_N1M = 4 * MiB, WS_GUM = 4 * MiB + 64 * KiB, WS_H1MF = 4 * MiB + 448 * KiB, WS_PM = 4 * MiB + 512 * KiB, WS_ST0 = 4 * MiB + 640 * KiB, WS_ZM = 4 * MiB + 896 * KiB, WS_A16 = 4 * MiB + 928 * KiB;
constexpr size_t WS_WGU1 = 8 * MiB, WS_WD1 = 19 * MiB, WS_Y = 8 * MiB;
constexpr size_t WS_WMAIN = 25 * MiB, WS_H1B = 29 * MiB, WS_WKV = 61 * MiB, WS_KVT = 29 * MiB;
constexpr size_t WS_WGLU = 63 * MiB, WS_WOUT = 64 * MiB, WS_WGU2 = 66 * MiB, WS_WD2 = 77 * MiB, WS_WY = 83 * MiB, WS_WZ = 89 * MiB, WS_ROT = 93 * MiB;
constexpr size_t WS_ACT = 98 * MiB, WS_Q = 98 * MiB, WS_K = 114 * MiB, WS_G = 130 * MiB, WS_KWT = 146 * MiB, WS_VT = 162 * MiB;
constexpr size_t WS_N1 = 186 * MiB, WS_UA = 186 * MiB, WS_MIX = 186 * MiB, WS_Z = 218 * MiB, WS_SPT = 234 * MiB, WS_END = 250 * MiB;

struct Args { const float* in[26]; float* out; unsigned char* ws; int ph_lo, ph_hi; };

__device__ __forceinline__ unsigned pk2(float lo, float hi) { unsigned r; asm volatile("v_cvt_pk_bf16_f32 %0, %1, %2" : "=v"(r) : "v"(lo), "v"(hi)); return r; }
__device__ __forceinline__ u32x4 pk8(f32x4 a, f32x4 b) { u32x4 w; w.x = pk2(a[0], a[1]); w.y = pk2(a[2], a[3]); w.z = pk2(b[0], b[1]); w.w = pk2(b[2], b[3]); return w; }
__device__ __forceinline__ float bf2f(unsigned short b) { return __uint_as_float((unsigned)b << 16); }
__device__ __forceinline__ float bflo(unsigned w) { return __uint_as_float(w << 16); }
__device__ __forceinline__ float bfhi(unsigned w) { return __uint_as_float(w & 0xffff0000u); }
__device__ __forceinline__ float sigmoidf_(float x) { return __builtin_amdgcn_rcpf(1.0f + __expf(-x)); }
__device__ __forceinline__ float siluf_(float x) { return x * sigmoidf_(x); }
__device__ __forceinline__ float gelu_tanh(float y) { return y * sigmoidf_(1.5957691216057308f * (y + 0.044715f * y * y * y)); }
__device__ __forceinline__ float wave_sum(float v) {
#pragma unroll
    for (int o = 1; o < 64; o <<= 1) v += __shfl_xor(v, o);
    return v;
}
__device__ __forceinline__ float sum4(f32x4 a) { return (a[0] + a[1]) + (a[2] + a[3]); }
__device__ __forceinline__ float sumsq4(f32x4 a) { return (a[0] * a[0] + a[1] * a[1]) + (a[2] * a[2] + a[3] * a[3]); }
__device__ __forceinline__ float rstd16(const float* ssq, int row) { return 1.0f / sqrtf(ssq[row] * (1.0f / 1024.0f) + EPS); }
__device__ __forceinline__ float ms8(const float* ssq, int row) { return ssq[row] * (1.0f / 512.0f) + EPS; }
__device__ __forceinline__ void ssq_add(float* p, float v) { (void)__hip_atomic_fetch_add(p, v, __ATOMIC_RELAXED, __HIP_MEMORY_SCOPE_AGENT); }
__device__ __forceinline__ float log2gamma(int h) { return log2f(1.0f - exp2f(-5.0f - (float)h)); }
__device__ __forceinline__ f32x4 mfma16(bf16x8 a, bf16x8 b, f32x4 c) { return __builtin_amdgcn_mfma_f32_16x16x32_bf16(a, b, c, 0, 0, 0); }

enum { MAP_PLAIN = 0, MAP_GU0 = 1, MAP_GU1 = 2, MAP_ROT = 3 };
struct TJob { const float* W; int ldw, col0, ncols, k0, kcnt; bf16* dst; int ldt, map, row_off; const float* ks; int ks_off; };
__device__ __forceinline__ int map_row(int map, int row_off, int n) {
    if (map == MAP_PLAIN) return row_off + n;
    if (map == MAP_GU0) return 256 * (n >> 7) + (n & 127);
    if (map == MAP_GU1) return 256 * (n >> 7) + 128 + (n & 127);
    const int h = n >> 7, d = n & 127; return row_off + 256 * (h >> 1) + 128 * (d >> 6) + 64 * (h & 1) + (d & 63);
}
constexpr int NJOBS = 15;
__device__ __forceinline__ TJob get_job(int j, const Args& a) {
    unsigned char* ws = a.ws; TJob t;
    t.W = nullptr; t.ldw = 0; t.col0 = 0; t.ncols = 0; t.k0 = 0; t.kcnt = 0; t.dst = nullptr; t.ldt = 0; t.map = MAP_PLAIN; t.row_off = 0; t.ks = nullptr; t.ks_off = 0;
    switch (j) {
    case 0: t.W = a.in[3]; t.ldw = FF; t.ncols = FF; t.kcnt = DM; t.dst = (bf16*)(ws + WS_WGU1); t.ldt = DM; t.map = MAP_GU0; break;
    case 1: t.W = a.in[4]; t.ldw = FF; t.ncols = FF; t.kcnt = DM; t.dst = (bf16*)(ws + WS_WGU1); t.ldt = DM; t.map = MAP_GU1; break;
    case 2: t.W = a.in[5]; t.ldw = DM; t.ncols = DM; t.kcnt = FF; t.dst = (bf16*)(ws + WS_WD1); t.ldt = FF; break;
    case 3: t.W = a.in[7]; t.ldw = 2560; t.col0 = 0; t.ncols = 512; t.kcnt = DM; t.dst = (bf16*)(ws + WS_WMAIN); t.ldt = DM; t.map = MAP_ROT; t.row_off = 0; t.ks = a.in[6]; break;
    case 4: t.W = a.in[7]; t.ldw = 2560; t.col0 = 512; t.ncols = 512; t.kcnt = DM; t.dst = (bf16*)(ws + WS_WMAIN); t.ldt = DM; t.map = MAP_ROT; t.row_off = 512; t.ks = a.in[6]; break;
    case 5: t.W = a.in[7]; t.ldw = 2560; t.col0 = 1536; t.ncols = 512; t.kcnt = DM; t.dst = (bf16*)(ws + WS_WMAIN); t.ldt = DM; t.row_off = 1024; t.ks = a.in[6]; break;
    case 6: t.W = a.in[7]; t.ldw = 2560; t.col0 = 2048; t.ncols = 512; t.kcnt = DM; t.dst = (bf16*)(ws + WS_WMAIN); t.ldt = DM; t.row_off = 1536; t.ks = a.in[6]; break;
    case 7: t.W = a.in[7]; t.ldw = 2560; t.col0 = 512; t.ncols = 512; t.kcnt = DM; t.dst = (bf16*)(ws + WS_WKV); t.ldt = DM; t.map = MAP_ROT; t.row_off = 0; t.ks = a.in[6]; break;
    case 8: t.W = a.in[7]; t.ldw = 2560; t.col0 = 1024; t.ncols = 512; t.kcnt = DM; t.dst = (bf16*)(ws + WS_WKV); t.ldt = DM; t.row_off = 512; t.ks = a.in[6]; break;
    case 9: t.W = a.in[17]; t.ldw = 512; t.ncols = 512; t.kcnt = 512; t.dst = (bf16*)(ws + WS_WGLU); t.ldt = 512; break;
    case 10: t.W = a.in[20]; t.ldw = DM; t.ncols = DM; t.k0 = 0; t.kcnt = 512; t.dst = (bf16*)(ws + WS_WOUT); t.ldt = DM; break;
    case 11: t.W = a.in[20]; t.ldw = DM; t.ncols = DM; t.k0 = 512; t.kcnt = 512; t.dst = (bf16*)(ws + WS_WOUT); t.ldt = DM; t.ks = a.in[19]; t.ks_off = 512; break;
    case 12: t.W = a.in[22]; t.ldw = FF; t.ncols = FF; t.kcnt = DM; t.dst = (bf16*)(ws + WS_WGU2); t.ldt = DM; t.map = MAP_GU0; t.ks = a.in[21]; break;
    case 13: t.W = a.in[23]; t.ldw = FF; t.ncols = FF; t.kcnt = DM; t.dst = (bf16*)(ws + WS_WGU2); t.ldt = DM; t.map = MAP_GU1; t.ks = a.in[21]; break;
    default: t.W = a.in[24]; t.ldw = DM; t.ncols = DM; t.kcnt = FF; t.dst = (bf16*)(ws + WS_WD2); t.ldt = FF; break;
    }
    return t;
}
__device__ __forceinline__ void tr_item(const TJob& J, int item, LAS float* scr, int lane) {
    const int nblk = J.ncols >> 5, kb = item / nblk, nb = item - kb * nblk, k0 = J.k0 + 64 * kb, n0 = 32 * nb;
#pragma unroll
    for (int i = 0; i < 32; ++i) { const int kk = 2 * i + (lane >> 5); float v = J.W[(size_t)(k0 + kk) * J.ldw + J.col0 + n0 + (lane & 31)]; if (J.ks) v *= J.ks[k0 + kk - J.ks_off]; scr[kk * 33 + (lane & 31)] = v; }
    asm volatile("s_waitcnt lgkmcnt(0)" ::: "memory");
    const int c = lane & 7;
#pragma unroll
    for (int j = 0; j < 4; ++j) { const int n = (lane >> 3) + 8 * j; const LAS float* s = scr + (8 * c) * 33 + n;
        u32x4 o; o.x = pk2(s[0 * 33], s[1 * 33]); o.y = pk2(s[2 * 33], s[3 * 33]); o.z = pk2(s[4 * 33], s[5 * 33]); o.w = pk2(s[6 * 33], s[7 * 33]);
        *(u32x4*)(J.dst + (size_t)map_row(J.map, J.row_off, n0 + n) * J.ldt + k0 + 8 * c) = o; }
    asm volatile("s_waitcnt lgkmcnt(0)" ::: "memory");
}
__device__ __forceinline__ void tr_load(const TJob& J, int item, f32x2 (&r)[32], int lane) {
    const int nblk = J.ncols >> 7, kb = item / nblk, nb = item - kb * nblk, k0 = J.k0 + 32 * kb, n0 = 128 * nb;
    const float* wp = J.W + (size_t)k0 * J.ldw + J.col0 + n0 + 2 * lane;
    if (J.ks) { const float* kp = J.ks + (k0 - J.ks_off);
#pragma unroll
        for (int kk = 0; kk < 32; ++kk) r[kk] = *(const f32x2*)(wp + (size_t)kk * J.ldw) * kp[kk];
    } else {
#pragma unroll
        for (int kk = 0; kk < 32; ++kk) r[kk] = *(const f32x2*)(wp + (size_t)kk * J.ldw);
    }
}
__device__ __forceinline__ void tr_put(const f32x2 (&r)[32], LAS float* scr, int lane) {
#pragma unroll
    for (int kk = 0; kk < 32; ++kk) { scr[kk * 129 + 2 * lane] = r[kk].x; scr[kk * 129 + 2 * lane + 1] = r[kk].y; }
    asm volatile("s_waitcnt lgkmcnt(0)" ::: "memory");
}
__device__ __forceinline__ void tr_flush(const TJob& J, int item, LAS float* scr, int lane) {
    const int nblk = J.ncols >> 7, kb = item / nblk, nb = item - kb * nblk, k0 = J.k0 + 32 * kb, n0 = 128 * nb, c = lane & 3;
#pragma unroll
    for (int j = 0; j < 8; ++j) { const int n = (lane >> 2) + 16 * j; const LAS float* s = scr + (8 * c) * 129 + n;
        u32x4 o; o.x = pk2(s[0 * 129], s[1 * 129]); o.y = pk2(s[2 * 129], s[3 * 129]); o.z = pk2(s[4 * 129], s[5 * 129]); o.w = pk2(s[6 * 129], s[7 * 129]);
        *(u32x4*)(J.dst + (size_t)map_row(J.map, J.row_off, n0 + n) * J.ldt + k0 + 8 * c) = o; }
    asm volatile("s_waitcnt lgkmcnt(0)" ::: "memory");
}
struct TrIter { int it, j, base, cnt, jend, limit, valid, pad_; TJob J; };
__device__ __forceinline__ void tr_seek(TrIter& I, const Args& a) {
    while (I.j < I.jend && I.it >= I.base + I.cnt) { I.base += I.cnt; ++I.j; if (I.j < I.jend) { I.J = get_job(I.j, a); I.cnt = (I.J.kcnt >> 5) * (I.J.ncols >> 7); } }
    I.valid = (I.j < I.jend && I.it < I.limit) ? 1 : 0;
}
__device__ __forceinline__ void tr_run(const Args& a, int j0, int jend, int it0, int stride, LAS float* scr, int lane, int limit = 0x7fffffff) {
    TrIter I; I.it = it0; I.j = j0; I.base = 0; I.jend = jend; I.limit = limit; I.valid = 0; I.pad_ = 0; I.J = get_job(j0, a); I.cnt = (I.J.kcnt >> 5) * (I.J.ncols >> 7); tr_seek(I, a);
    f32x2 r[32];
    if (I.valid) tr_load(I.J, I.it - I.base, r, lane);
    while (I.valid) {
        TrIter N = I; N.it += stride; tr_seek(N, a);
        tr_put(r, scr, lane);
        if (N.valid) tr_load(N.J, N.it - N.base, r, lane);
        tr_flush(I.J, I.it - I.base, scr, lane);
        I = N;
    }
}
__device__ __forceinline__ void rms_rows4_to_bf16(const float* x0, size_t xstride, const float* w, bf16* o0, size_t ostride, int lane) {
    f32x4 v[4][4]; const f32x4* wr = (const f32x4*)w + lane;
#pragma unroll
    for (int q = 0; q < 4; ++q)
#pragma unroll
        for (int j = 0; j < 4; ++j) v[q][j] = ((const f32x4*)(x0 + q * xstride) + lane)[64 * j];
    float rs[4];
#pragma unroll
    for (int q = 0; q < 4; ++q) { float ss = 0.f;
#pragma unroll
        for (int j = 0; j < 4; ++j) ss += sumsq4(v[q][j]);
        rs[q] = 1.0f / sqrtf(wave_sum(ss) * (1.0f / 1024.0f) + EPS); }
#pragma unroll
    for (int j = 0; j < 4; ++j) { const f32x4 g = wr[64 * j];
#pragma unroll
        for (int q = 0; q < 4; ++q) { u32x2 o; o.x = pk2(v[q][j][0] * rs[q] * g[0], v[q][j][1] * rs[q] * g[1]); o.y = pk2(v[q][j][2] * rs[q] * g[2], v[q][j][3] * rs[q] * g[3]); ((u32x2*)(o0 + q * ostride) + lane)[64 * j] = o; } }
}
__device__ __forceinline__ void rms_row_to_bf16(const float* xrow, const float* w, bf16* orow, int lane) {
    const f32x4* xr = (const f32x4*)xrow + lane; const f32x4* wr = (const f32x4*)w + lane;
    f32x4 v[4]; float s = 0.f;
#pragma unroll
    for (int j = 0; j < 4; ++j) { v[j] = xr[64 * j]; s += sumsq4(v[j]); }
    const float rstd = 1.0f / sqrtf(wave_sum(s) * (1.0f / 1024.0f) + EPS);
    u32x2* o8 = (u32x2*)orow + lane;
#pragma unroll
    for (int j = 0; j < 4; ++j) { const f32x4 g = wr[64 * j]; u32x2 o; o.x = pk2(v[j][0] * rstd * g[0], v[j][1] * rstd * g[1]); o.y = pk2(v[j][2] * rstd * g[2], v[j][3] * rstd * g[3]); o8[64 * j] = o; }
}
__device__ __forceinline__ void rms_rows2_to_bf16(const float* xa, const float* xb, const float* w, bf16* oa, bf16* ob, int lane) {
    const f32x4* pa = (const f32x4*)xa + lane; const f32x4* pb = (const f32x4*)xb + lane; const f32x4* wr = (const f32x4*)w + lane;
    f32x4 va[4], vb[4]; float sa = 0.f, sb = 0.f;
#pragma unroll
    for (int j = 0; j < 4; ++j) { va[j] = pa[64 * j]; vb[j] = pb[64 * j]; }
#pragma unroll
    for (int j = 0; j < 4; ++j) { sa += sumsq4(va[j]); sb += sumsq4(vb[j]); }
    const float ra = 1.0f / sqrtf(wave_sum(sa) * (1.0f / 1024.0f) + EPS), rb = 1.0f / sqrtf(wave_sum(sb) * (1.0f / 1024.0f) + EPS);
    u32x2* qa = (u32x2*)oa + lane; u32x2* qb = (u32x2*)ob + lane;
#pragma unroll
    for (int j = 0; j < 4; ++j) { const f32x4 g = wr[64 * j]; u32x2 o; o.x = pk2(va[j][0] * ra * g[0], va[j][1] * ra * g[1]); o.y = pk2(va[j][2] * ra * g[2], va[j][3] * ra * g[3]); qa[64 * j] = o;
        o.x = pk2(vb[j][0] * rb * g[0], vb[j][1] * rb * g[1]); o.y = pk2(vb[j][2] * rb * g[2], vb[j][3] * rb * g[3]); qb[64 * j] = o; }
}
__device__ __forceinline__ f32x2 cmul(f32x2 a, f32x2 b) { return (f32x2){a.x * b.x - a.y * b.y, a.x * b.y + a.y * b.x}; }

__device__ __forceinline__ void ssm_mats(const Args& a, int g, LAS unsigned char* lds, int tid) {
    LAS f32x2* apow = (LAS f32x2*)lds;
    LAS f32x2* bbar = apow + 17 * 64;
    LAS f32x2* Cc = bbar + 1024;
    LAS float* Km = (LAS float*)(Cc + 1024);
    LAS f32x2* cfs = (LAS f32x2*)(Km + 4096);
    unsigned char* ws = a.ws;
    for (int idx = tid; idx < 17 * 64; idx += NTHR) {
        const int j = idx >> 6, n = idx & 63; const float lre = a.in[9][g * 64 + n], lim = a.in[10][g * 64 + n], dt = expf(a.in[11][g]);
        const float mag = expf((float)j * lre * dt); float sn, cs; sincosf((float)j * (lim * dt), &sn, &cs); const f32x2 ap = (f32x2){mag * cs, mag * sn}; apow[idx] = ap;
        if (j == 16) ((f32x2*)(ws + WS_A16))[g * 64 + n] = ap;
        if (j == 1) { const float nx = ap.x - 1.0f, ny = ap.y, den = lre * lre + lim * lim; cfs[n] = (f32x2){(nx * lre + ny * lim) / den, (ny * lre - nx * lim) / den}; }
    }
    __syncthreads();
    for (int idx = tid; idx < 1024; idx += NTHR) {
        { const int n = idx >> 4, q = idx & 15; const f32x2 b = (f32x2){a.in[12][(size_t)(g * 64 + n) * 16 + q], a.in[13][(size_t)(g * 64 + n) * 16 + q]}; bbar[idx] = cmul(cfs[n], b); }
        { const int p = idx >> 6, n = idx & 63; Cc[idx] = (f32x2){a.in[14][(size_t)(g * 16 + p) * 64 + n], a.in[15][(size_t)(g * 16 + p) * 64 + n]}; }
    }
    __syncthreads();
    {
        const int j = tid >> 5, p = (tid >> 1) & 15, qh = tid & 1; float acc[8];
#pragma unroll
        for (int q = 0; q < 8; ++q) acc[q] = 0.f;
        for (int n = 0; n < 64; ++n) { const f32x2 ca = cmul(Cc[p * 64 + n], apow[j * 64 + n]);
#pragma unroll
            for (int q = 0; q < 8; ++q) { const f32x2 b = bbar[n * 16 + qh * 8 + q]; acc[q] += ca.x * b.x - ca.y * b.y; } }
#pragma unroll
        for (int q = 0; q < 8; ++q) Km[(j * 16 + p) * 16 + qh * 8 + q] = acc[q];
    }
    __syncthreads();
    bf16* WY = (bf16*)(ws + WS_WY) + (size_t)g * 256 * 384; bf16* WZ = (bf16*)(ws + WS_WZ) + (size_t)g * 256 * 256;
    for (int idx = tid; idx < 256 * 192; idx += NTHR) {
        const int r = idx / 192, c = 2 * (idx - r * 192), t = r >> 4, p = r & 15; float v0, v1;
        if (c < 256) { const int s = c >> 4, q = c & 15; if (t >= s) { v0 = Km[((t - s) * 16 + p) * 16 + q]; v1 = Km[((t - s) * 16 + p) * 16 + q + 1]; } else { v0 = 0.f; v1 = 0.f; } }
        else { const int nn = c - 256, n = nn & 63; const f32x2 c0 = cmul(Cc[p * 64 + n], apow[(t + 1) * 64 + n]), c1 = cmul(Cc[p * 64 + n + 1], apow[(t + 1) * 64 + n + 1]);
            if (nn < 64) { v0 = c0.x; v1 = c1.x; } else { v0 = -c0.y; v1 = -c1.y; } }
        *(unsigned*)(WY + (size_t)r * 384 + c) = pk2(v0, v1);
    }
    for (int idx = tid; idx < 256 * 128; idx += NTHR) {
        const int r = idx >> 7, c = 2 * (idx & 127), s = c >> 4, q = c & 15; float v0 = 0.f, v1 = 0.f;
        if (r < 128) { const int n = r & 63; const f32x2 z0 = cmul(apow[(15 - s) * 64 + n], bbar[n * 16 + q]), z1 = cmul(apow[(15 - s) * 64 + n], bbar[n * 16 + q + 1]);
            if (r < 64) { v0 = z0.x; v1 = z1.x; } else { v0 = z0.y; v1 = z1.y; } }
        *(unsigned*)(WZ + (size_t)r * 256 + c) = pk2(v0, v1);
    }
    __syncthreads();
}

template <class AL, class EP>
__device__ __forceinline__ void skinny(const bf16* Bt, int ldb, int ngroups, int nsplit, int K, int task0, int ntask_stride, const AL& al, const EP& ep, int lane) {
    const int fr = lane & 15, fq = lane >> 4, kper = K / nsplit;
    for (int t = task0; t < ngroups * nsplit; t += ntask_stride) {
        const int grp = t % ngroups, sp = t / ngroups;
        f32x4 acc = (f32x4){0.f, 0.f, 0.f, 0.f};
        const bf16* bp = Bt + (size_t)(grp * 16 + fr) * ldb + fq * 8;
#pragma unroll 4
        for (int k = sp * kper; k < (sp + 1) * kper; k += 32) { const bf16x8 b = *(const bf16x8*)(bp + k); const bf16x8 av = al(fr, k + fq * 8); acc = mfma16(b, av, acc); }
        ep(fr, grp * 16 + fq * 4, acc);
    }
}
struct ALBf16 { const bf16* A; int lda; __device__ __forceinline__ bf16x8 operator()(int r, int k) const { return *(const bf16x8*)(A + (size_t)r * lda + k); } };
struct ALF32 { const float* A; int lda; __device__ __forceinline__ bf16x8 operator()(int r, int k) const { const f32x4* p = (const f32x4*)(A + (size_t)r * lda + k); return __builtin_bit_cast(bf16x8, pk8(p[0], p[1])); } };
struct ALSwiGLU { const float* GU; __device__ __forceinline__ bf16x8 operator()(int r, int k) const {
        const float* p = GU + (size_t)r * 5632 + 256 * (k >> 7) + (k & 127); const f32x4 g0 = *(const f32x4*)p, g1 = *(const f32x4*)(p + 4), u0 = *(const f32x4*)(p + 128), u1 = *(const f32x4*)(p + 132); f32x4 a0, a1;
#pragma unroll
        for (int e = 0; e < 4; ++e) { a0[e] = siluf_(g0[e]) * u0[e]; a1[e] = siluf_(g1[e]) * u1[e]; }
        return __builtin_bit_cast(bf16x8, pk8(a0, a1)); } };
struct EPStore { float* O; int ldo; __device__ __forceinline__ void operator()(int r, int c, f32x4 v) const { *(f32x4*)(O + (size_t)r * ldo + c) = v; } };
struct EPAtomic { float* O; int ldo; float sc; __device__ __forceinline__ void operator()(int r, int c, f32x4 v) const { float* p = O + (size_t)r * ldo + c;
#pragma unroll
        for (int e = 0; e < 4; ++e) ssq_add(p + e, sc * v[e]); } };

struct P3Order {
    int G, c;
    __device__ bool next(int i, Unit& u) const {
        if (G == 256) { if (i > 2) return false; const int c4 = c >> 2, sub = c & 3;
            if (i < 2) { u.pm = c4; u.pn = (sub < 2) ? (4 + 2 * i + sub) : (2 * i + sub - 2); } else { u.pn = 8 + c4; u.pm = 64 + sub; } return true; }
        const int L = i * G + c; if (L >= 768) return false;
        if (L < 512) { u.pm = L >> 3; u.pn = L & 7; } else { const int l = L - 512; u.pn = 8 + (l >> 2); u.pm = 64 + (l & 3); } return true; }
    __device__ __forceinline__ void a_ready(const Unit&) const {}
    __device__ __forceinline__ void done(const Unit&) const {}
};
struct GroupOrder {
    int G, c;
    __device__ bool next(int i, Unit& u) const { const int L = i * G + c; if (L >= 128) return false; u.pm = L; u.pn = L >> 2; return true; }
    __device__ __forceinline__ void a_ready(const Unit&) const {}
    __device__ __forceinline__ void done(const Unit&) const {}
};

struct EpiSwiGLU {
    static constexpr bool PERM = true, AFTER_DRAIN = false, HAS_MID = false;
    bf16* O; const float* ssq;
    __device__ __forceinline__ void operator()(const f32x4 (&acc)[2][2][4][2], const Unit& u, int wr, int wc, int fr, int fq) const {
        asm volatile("" : "+v"(fr), "+v"(fq));
        const int col0 = u.pn * 128 + wc * 32 + 8 * fq;
#pragma unroll
        for (int ai = 0; ai < 2; ++ai)
#pragma unroll
            for (int m = 0; m < 4; ++m) { const int row = u.pm * 256 + ai * 128 + wr * 64 + m * 16 + fr; const float rs = ssq ? rstd16(ssq, row) : 1.0f;
                f32x4 a0, a1;
#pragma unroll
                for (int e = 0; e < 4; ++e) { a0[e] = siluf_(acc[ai][0][m][0][e] * rs) * (acc[ai][1][m][0][e] * rs); a1[e] = siluf_(acc[ai][0][m][1][e] * rs) * (acc[ai][1][m][1][e] * rs); }
                *(u32x4*)(O + (size_t)row * FF + col0) = pk8(a0, a1); asm volatile("" ::: "memory"); }
    }
};
template <int MODE>
struct EpiRes {
    static constexpr bool PERM = true, AFTER_DRAIN = false, HAS_MID = (MODE == 1); static constexpr int MID_T = 8;
    const float* base; float* out; bf16* hb; float* ssq_out; const float* ssqg;
    __device__ __forceinline__ void mid(f32x4 (&acc)[2][2][4][2], const Unit& u, int wr, int fr) const {
#pragma unroll
        for (int ai = 0; ai < 2; ++ai)
#pragma unroll
            for (int m = 0; m < 4; ++m) { const int row = u.pm * 256 + ai * 128 + wr * 64 + m * 16 + fr; const float f = sqrtf(ms8(ssqg, row));
#pragma unroll
                for (int bj = 0; bj < 2; ++bj)
#pragma unroll
                    for (int n = 0; n < 2; ++n) acc[ai][bj][m][n] = acc[ai][bj][m][n] * f; }
    }
    __device__ __forceinline__ void operator()(const f32x4 (&acc)[2][2][4][2], const Unit& u, int wr, int wc, int fr, int fq) const {
        asm volatile("" : "+v"(fr), "+v"(fq));
#pragma unroll
        for (int ai = 0; ai < 2; ++ai)
#pragma unroll
            for (int m = 0; m < 4; ++m) { const int row = u.pm * 256 + ai * 128 + wr * 64 + m * 16 + fr; const float sc = MODE == 0 ? 0.5f : 1.0f / sqrtf(ms8(ssqg, row)); float ss = 0.f;
#pragma unroll
                for (int bj = 0; bj < 2; ++bj) { const size_t off = (size_t)row * DM + u.pn * 256 + bj * 128 + wc * 32 + 8 * fq;
                    const f32x4 b0 = *(const f32x4*)(base + off), b1 = *(const f32x4*)(base + off + 4); const f32x4 h0 = b0 + sc * acc[ai][bj][m][0], h1 = b1 + sc * acc[ai][bj][m][1];
                    *(f32x4*)(out + off) = h0; *(f32x4*)(out + off + 4) = h1; if (hb) *(u32x4*)(hb + off) = pk8(h0, h1); ss += sumsq4(h0) + sumsq4(h1); }
                ss += __shfl_xor(ss, 16); ss += __shfl_xor(ss, 32);
                if (fq == 0) ssq_add(ssq_out + row, ss); asm volatile("" ::: "memory"); }
    }
};
struct EpiFinal {
    static constexpr bool PERM = true, AFTER_DRAIN = false, HAS_MID = false;
    const float* base; float* out; float* ssq; unsigned* cnt; const float* w;
    __device__ __forceinline__ void operator()(f32x4 (&acc)[2][2][4][2], const Unit& u, int wr, int wc, int fr, int fq) const {
        asm volatile("" : "+v"(fr), "+v"(fq));
#pragma unroll
        for (int ai = 0; ai < 2; ++ai)
#pragma unroll
            for (int m = 0; m < 4; ++m) { const int row = u.pm * 256 + ai * 128 + wr * 64 + m * 16 + fr; float ss = 0.f;
#pragma unroll
                for (int bj = 0; bj < 2; ++bj) { const size_t off = (size_t)row * DM + u.pn * 256 + bj * 128 + wc * 32 + 8 * fq;
                    const f32x4 b0 = *(const f32x4*)(base + off), b1 = *(const f32x4*)(base + off + 4); const f32x4 h0 = b0 + 0.5f * acc[ai][bj][m][0], h1 = b1 + 0.5f * acc[ai][bj][m][1];
                    acc[ai][bj][m][0] = h0; acc[ai][bj][m][1] = h1; ss += sumsq4(h0) + sumsq4(h1); }
                ss += __shfl_xor(ss, 16); ss += __shfl_xor(ss, 32);
                if (fq == 0) ssq_add(ssq + row, ss); asm volatile("" ::: "memory"); }
        asm volatile("s_waitcnt vmcnt(0)" ::: "memory");
        unsigned* c = cnt + 64 * u.pm;
        if (fr == 0 && fq == 0) (void)__hip_atomic_fetch_add(c, 1u, __ATOMIC_RELAXED, __HIP_MEMORY_SCOPE_AGENT);
        for (unsigned sp = 0; sp < (1u << 20); ++sp) { if ((unsigned)__builtin_amdgcn_readfirstlane(__hip_atomic_load(c, __ATOMIC_RELAXED, __HIP_MEMORY_SCOPE_AGENT)) >= 32u) break; __builtin_amdgcn_s_sleep(2); }
        asm volatile("" ::: "memory");
#pragma unroll
        for (int ai = 0; ai < 2; ++ai)
#pragma unroll
            for (int m = 0; m < 4; ++m) { const int row = u.pm * 256 + ai * 128 + wr * 64 + m * 16 + fr;
                const float rs = 1.0f / sqrtf(__hip_atomic_load(ssq + row, __ATOMIC_RELAXED, __HIP_MEMORY_SCOPE_AGENT) * (1.0f / 1024.0f) + EPS);
#pragma unroll
                for (int bj = 0; bj < 2; ++bj) { const int col = u.pn * 256 + bj * 128 + wc * 32 + 8 * fq; const size_t off = (size_t)row * DM + col;
                    const f32x4 w0 = *(const f32x4*)(w + col), w1 = *(const f32x4*)(w + col + 4);
                    *(f32x4*)(out + off) = acc[ai][bj][m][0] * rs * w0; *(f32x4*)(out + off + 4) = acc[ai][bj][m][1] * rs * w1; }
                asm volatile("" ::: "memory"); }
    }
};
struct EpiInProj {
    static constexpr bool PERM = true, AFTER_DRAIN = false, HAS_MID = false;
    const float* ssq1; const f32x2* rot; bf16 *Q, *K, *G, *UA, *KWT, *VT;
    __device__ __forceinline__ void operator()(const f32x4 (&acc)[2][2][4][2], const Unit& u, int wr, int wc, int fr, int fq) const {
        asm volatile("" : "+v"(fr), "+v"(fq));
        if (u.pm < 64) {
#ifndef NO_NORMAL
            const int pn = u.pn;
            if (pn < 4) {
                bf16* O = pn < 2 ? Q : K; const float sc = pn < 2 ? 1.0f : 0.08838834764831845f; const int p0 = wc * 32 + 8 * fq, head = 2 * (pn & 1) + (p0 >> 6), i0 = p0 & 63;
#pragma unroll
                for (int ai = 0; ai < 2; ++ai)
#pragma unroll
                    for (int m = 0; m < 4; ++m) { const int row = u.pm * 256 + ai * 128 + wr * 64 + m * 16 + fr; const float rs = rstd16(ssq1, row) * sc; const int pos = 16 + (row & 8191);
                        const f32x4* rp = (const f32x4*)(rot + (size_t)pos * 64 + i0); f32x4 o1[2], o2[2];
#pragma unroll
                        for (int n = 0; n < 2; ++n) { const f32x4 ra = rp[2 * n], rb = rp[2 * n + 1]; const f32x4 x1 = acc[ai][0][m][n], x2 = acc[ai][1][m][n];
                            o1[n][0] = (x1[0] * ra[0] - x2[0] * ra[1]) * rs; o2[n][0] = (x1[0] * ra[1] + x2[0] * ra[0]) * rs;
                            o1[n][1] = (x1[1] * ra[2] - x2[1] * ra[3]) * rs; o2[n][1] = (x1[1] * ra[3] + x2[1] * ra[2]) * rs;
                            o1[n][2] = (x1[2] * rb[0] - x2[2] * rb[1]) * rs; o2[n][2] = (x1[2] * rb[1] + x2[2] * rb[0]) * rs;
                            o1[n][3] = (x1[3] * rb[2] - x2[3] * rb[3]) * rs; o2[n][3] = (x1[3] * rb[3] + x2[3] * rb[2]) * rs; }
                        bf16* op = O + (size_t)row * 512 + head * 128 + i0; *(u32x4*)op = pk8(o1[0], o1[1]); *(u32x4*)(op + 64) = pk8(o2[0], o2[1]); asm volatile("" ::: "memory"); if (m & 1) __builtin_amdgcn_sched_barrier(0); }
            } else if (pn < 6) {
#pragma unroll
                for (int ai = 0; ai < 2; ++ai)
#pragma unroll
                    for (int m = 0; m < 4; ++m) { const int row = u.pm * 256 + ai * 128 + wr * 64 + m * 16 + fr; const float rs = rstd16(ssq1, row);
#pragma unroll
                        for (int bj = 0; bj < 2; ++bj) *(u32x4*)(G + (size_t)row * 512 + (pn - 4) * 256 + bj * 128 + wc * 32 + 8 * fq) = pk8(acc[ai][bj][m][0] * rs, acc[ai][bj][m][1] * rs); }
            } else {
#pragma unroll
                for (int ai = 0; ai < 2; ++ai)
#pragma unroll
                    for (int m = 0; m < 4; ++m) { const int row = u.pm * 256 + ai * 128 + wr * 64 + m * 16 + fr; const float rs = rstd16(ssq1, row); const int chunk = row >> 4, s = row & 15;
#pragma unroll
                        for (int bj = 0; bj < 2; ++bj) { const int ch = (pn - 6) * 256 + bj * 128 + wc * 32 + 8 * fq;
                            *(u32x4*)(UA + ((size_t)(ch >> 4) * 1024 + chunk) * 384 + s * 16 + (ch & 15)) = pk8(acc[ai][bj][m][0] * rs, acc[ai][bj][m][1] * rs); } }
            }
#endif
        } else {
#ifndef NO_SWAP
            const int tokb = (u.pn - 8) * 256 + wc * 32 + 8 * fq;
            if (u.pm < 66) {
                const int head = 2 * (u.pm - 64) + wr; const float l2g = log2gamma(head);
#pragma unroll
                for (int bj = 0; bj < 2; ++bj) { const int tok0 = tokb + bj * 128; float rs[8];
#pragma unroll
                    for (int e = 0; e < 8; ++e) rs[e] = rstd16(ssq1, tok0 + e) * 0.08838834764831845f * exp2f(l2g * (float)(127 - ((tok0 + e) & 127)));
#pragma unroll
                    for (int m = 0; m < 4; ++m) { const int i = 16 * m + fr; f32x4 o1[2], o2[2];
#pragma unroll
                        for (int e = 0; e < 8; ++e) { const int pos = 16 + ((tok0 + e) & 8191); const f32x2 cs = rot[(size_t)pos * 64 + i]; const float x1 = acc[0][bj][m][e >> 2][e & 3], x2 = acc[1][bj][m][e >> 2][e & 3];
                            o1[e >> 2][e & 3] = (x1 * cs.x - x2 * cs.y) * rs[e]; o2[e >> 2][e & 3] = (x1 * cs.y + x2 * cs.x) * rs[e]; }
                        *(u32x4*)(KWT + (size_t)(head * 128 + i) * NT + tok0) = pk8(o1[0], o1[1]); *(u32x4*)(KWT + (size_t)(head * 128 + 64 + i) * NT + tok0) = pk8(o2[0], o2[1]); asm volatile("" ::: "memory"); __builtin_amdgcn_sched_barrier(0); } }
            } else {
#pragma unroll
                for (int bj = 0; bj < 2; ++bj) { const int tok0 = tokb + bj * 128; f32x4 r0, r1;
#pragma unroll
                    for (int e = 0; e < 4; ++e) { r0[e] = rstd16(ssq1, tok0 + e); r1[e] = rstd16(ssq1, tok0 + 4 + e); }
#pragma unroll
                    for (int ai = 0; ai < 2; ++ai)
#pragma unroll
                        for (int m = 0; m < 4; ++m) { const int r = (u.pm - 66) * 256 + ai * 128 + wr * 64 + m * 16 + fr; *(u32x4*)(VT + (size_t)r * NT + tok0) = pk8(acc[ai][bj][m][0] * r0, acc[ai][bj][m][1] * r1); } }
            }
#endif
        }
    }
};
struct EpiZ {
    static constexpr bool PERM = true, AFTER_DRAIN = false, HAS_MID = false;
    float* Z;
    __device__ __forceinline__ void operator()(const f32x4 (&acc)[2][2][4][2], const Unit& u, int wr, int wc, int fr, int fq) const {
        asm volatile("" : "+v"(fr), "+v"(fq));
#pragma unroll
        for (int ai = 0; ai < 2; ++ai)
#pragma unroll
            for (int m = 0; m < 4; ++m) { const int row = u.pm * 256 + ai * 128 + wr * 64 + m * 16 + fr; float* p = Z + (size_t)row * 128 + wc * 32 + 8 * fq; *(f32x4*)p = acc[ai][0][m][0]; *(f32x4*)(p + 4) = acc[ai][0][m][1]; }
    }
};
struct EpiY {
    static constexpr bool PERM = true, AFTER_DRAIN = false, HAS_MID = false;
    const bf16* UA; const float* D; bf16* Y;
    __device__ __forceinline__ void operator()(const f32x4 (&acc)[2][2][4][2], const Unit& u, int wr, int wc, int fr, int fq) const {
        asm volatile("" : "+v"(fr), "+v"(fq));
        const int grp = u.pn, p0 = 8 * (fq & 1);
        const bf16* ub = UA + (size_t)(u.pm * 256 + wr * 64 + fr) * 384 + wc * 32 + 8 * fq;
        bf16* yb = Y + (size_t)((((u.pm & 3) * 256 + wr * 64 + fr) * 16) + wc * 2 + (fq >> 1)) * 512 + grp * 16 + p0;
        const f32x4 d0 = *(const f32x4*)(D + grp * 16 + p0), d1 = *(const f32x4*)(D + grp * 16 + p0 + 4);
#pragma unroll
        for (int ai = 0; ai < 2; ++ai)
#pragma unroll
            for (int m = 0; m < 4; ++m) {
#pragma unroll
                for (int bj = 0; bj < 2; ++bj) {
                    const u32x4 uv = *(const u32x4*)(ub + (ai * 128 + m * 16) * 384 + bj * 128);
                    f32x4 y0 = acc[ai][bj][m][0], y1 = acc[ai][bj][m][1];
                    y0[0] += d0[0] * bflo(uv.x); y0[1] += d0[1] * bfhi(uv.x); y0[2] += d0[2] * bflo(uv.y); y0[3] += d0[3] * bfhi(uv.y);
                    y1[0] += d1[0] * bflo(uv.z); y1[1] += d1[1] * bfhi(uv.z); y1[2] += d1[2] * bflo(uv.w); y1[3] += d1[3] * bfhi(uv.w);
#pragma unroll
                    for (int e = 0; e < 4; ++e) { y0[e] = gelu_tanh(y0[e]); y1[e] = gelu_tanh(y1[e]); }
                    *(u32x4*)(yb + (size_t)((ai * 128 + m * 16) * 16 + bj * 8) * 512) = pk8(y0, y1); __builtin_amdgcn_sched_barrier(0); }
                asm volatile("" ::: "memory"); }
    }
};
struct EpiGLU {
    static constexpr bool PERM = true, AFTER_DRAIN = false, HAS_MID = false;
    const bf16* Y; const float* bias; bf16* MIX; float* ssqg;
    __device__ __forceinline__ void operator()(const f32x4 (&acc)[2][2][4][2], const Unit& u, int wr, int wc, int fr, int fq) const {
        asm volatile("" : "+v"(fr), "+v"(fq));
#pragma unroll
        for (int ai = 0; ai < 2; ++ai)
#pragma unroll
            for (int m = 0; m < 4; ++m) { const int row = u.pm * 256 + ai * 128 + wr * 64 + m * 16 + fr; float ss = 0.f;
#pragma unroll
                for (int bj = 0; bj < 2; ++bj) { const int col = u.pn * 256 + bj * 128 + wc * 32 + 8 * fq;
                    const u32x4 yv = *(const u32x4*)(Y + (size_t)row * 512 + col); const f32x4 b0 = *(const f32x4*)(bias + col), b1 = *(const f32x4*)(bias + col + 4);
                    const f32x4 z0 = acc[ai][bj][m][0] + b0, z1 = acc[ai][bj][m][1] + b1; f32x4 y0, y1;
                    y0[0] = bflo(yv.x) * sigmoidf_(z0[0]); y0[1] = bfhi(yv.x) * sigmoidf_(z0[1]); y0[2] = bflo(yv.y) * sigmoidf_(z0[2]); y0[3] = bfhi(yv.y) * sigmoidf_(z0[3]);
                    y1[0] = bflo(yv.z) * sigmoidf_(z1[0]); y1[1] = bfhi(yv.z) * sigmoidf_(z1[1]); y1[2] = bflo(yv.w) * sigmoidf_(z1[2]); y1[3] = bfhi(yv.w) * sigmoidf_(z1[3]);
                    ss += sumsq4(y0) + sumsq4(y1); *(u32x4*)(MIX + (size_t)row * DM + 512 + col) = pk8(y0, y1); }
                ss += __shfl_xor(ss, 16); ss += __shfl_xor(ss, 32);
                if (fq == 0) ssq_add(ssqg + row, ss); asm volatile("" ::: "memory"); }
    }
};

#define LD16(off) (*(const bf16x8*)(ws + (off)))
#define LD8(off) (*(const u32x2*)(ws + (off)))
__device__ __forceinline__ void r1_item(int item, unsigned char* ws, int w, int lane) {
    const int bh = item >> 6, n = item & 63, b = bh >> 2, h = bh & 3, fr = lane & 15, fq = lane >> 4; const int tok0 = b * 8192 + n * 128;
    const unsigned voff = (unsigned)WS_VT + (unsigned)(((h * 128 + 16 * w + fr) * NT + tok0 + 8 * fq) * 2);
    const unsigned koff = (unsigned)WS_KWT + (unsigned)(((h * 128 + fr) * NT + tok0 + 8 * fq) * 2);
    bf16x8 vf[4];
#pragma unroll
    for (int ks = 0; ks < 4; ++ks) vf[ks] = LD16(voff + 64 * ks);
    const unsigned ooff = (unsigned)WS_KVT + (unsigned)((((bh * 64 + n) * 128 + 16 * w + 4 * fq) * 128 + fr) * 4);
#pragma unroll
    for (int dt = 0; dt < 8; ++dt) { f32x4 acc = (f32x4){0.f, 0.f, 0.f, 0.f};
#pragma unroll
        for (int ks = 0; ks < 4; ++ks) acc = mfma16(vf[ks], LD16(koff + (unsigned)(dt * 16 * NT * 2 + 64 * ks)), acc);
#pragma unroll
        for (int jj = 0; jj < 4; ++jj) *(float*)(ws + ooff + (unsigned)((jj * 128 + 16 * dt) * 4)) = acc[jj]; }
}
__device__ __forceinline__ void r3_item(int item, unsigned char* ws, const float* retw, int w, int lane) {
    const int bh = item >> 6, n = item & 63, b = bh >> 2, h = bh & 3, fr = lane & 15, fq = lane >> 4; const int tok0 = b * 8192 + n * 128, irow = tok0 + 16 * w + fr;
    const float l2g = log2gamma(h);
    const unsigned qoff = (unsigned)WS_Q + (unsigned)((irow * 512 + h * 128 + 8 * fq) * 2);
    const unsigned koff = (unsigned)WS_K + (unsigned)(((tok0 + fr) * 512 + h * 128 + 8 * fq) * 2);
    const unsigned voff = (unsigned)WS_VT + (unsigned)(((h * 128 + fr) * NT + tok0 + 4 * fq) * 2);
    const unsigned soff = (unsigned)WS_SPT + (unsigned)((((bh * 64 + n) * 128 + fr) * 128 + 8 * fq) * 2);
    const unsigned goff = (unsigned)WS_G + (unsigned)((irow * 512 + h * 128 + 4 * fq) * 2);
    const unsigned moff = (unsigned)WS_MIX + (unsigned)((irow * 1024 + h * 128 + 4 * fq) * 2);
    bf16x8 qf[4];
#pragma unroll
    for (int ks = 0; ks < 4; ++ks) qf[ks] = LD16(qoff + 64 * ks);
    f32x4 s[8];
#pragma unroll
    for (int jt = 0; jt < 8; ++jt) { s[jt] = (f32x4){0.f, 0.f, 0.f, 0.f};
        if (jt <= w) {
#pragma unroll
            for (int ks = 0; ks < 4; ++ks) s[jt] = mfma16(LD16(koff + (unsigned)(jt * 16 * 512 * 2 + 64 * ks)), qf[ks], s[jt]);
#pragma unroll
            for (int jj = 0; jj < 4; ++jj) { const int dd = 16 * (w - jt) + fr - 4 * fq - jj; s[jt][jj] = dd >= 0 ? s[jt][jj] * exp2f(l2g * (float)dd) : 0.f; } } }
    f32x4 o[8];
#pragma unroll
    for (int et = 0; et < 8; ++et) o[et] = (f32x4){0.f, 0.f, 0.f, 0.f};
#pragma unroll
    for (int kp = 0; kp < 4; ++kp) if (2 * kp <= w) { const bf16x8 sf = __builtin_bit_cast(bf16x8, pk8(s[2 * kp], s[2 * kp + 1]));
#pragma unroll
        for (int et = 0; et < 8; ++et) { const u32x2 v0 = LD8(voff + (unsigned)(et * 16 * NT * 2 + 64 * kp)), v1 = LD8(voff + (unsigned)(et * 16 * NT * 2 + 64 * kp + 32));
            const u32x4 vv = (u32x4){v0.x, v0.y, v1.x, v1.y}; o[et] = mfma16(__builtin_bit_cast(bf16x8, vv), sf, o[et]); } }
    const float wq = exp2f(l2g * (float)(16 * w + fr + 1)); float s1 = 0.f;
#pragma unroll
    for (int et = 0; et < 8; ++et) { f32x4 oc = (f32x4){0.f, 0.f, 0.f, 0.f};
#pragma unroll
        for (int ks = 0; ks < 4; ++ks) oc = mfma16(LD16(soff + (unsigned)(et * 16 * 128 * 2 + 64 * ks)), qf[ks], oc);
        o[et] = o[et] + wq * oc; s1 += sum4(o[et]); }
    s1 += __shfl_xor(s1, 16); s1 += __shfl_xor(s1, 32); const float mean = s1 * (1.0f / 128.0f); float s2 = 0.f;
#pragma unroll
    for (int et = 0; et < 8; ++et) { o[et] = o[et] - mean; s2 += sumsq4(o[et]); }
    s2 += __shfl_xor(s2, 16); s2 += __shfl_xor(s2, 32);
    const float msg = *(const float*)(ws + (unsigned)WS_SSQG + (unsigned)(irow * 4)) * (1.0f / 512.0f) + EPS;
    const float sc = (1.0f / sqrtf(s2 * (1.0f / 128.0f) + EPS)) * sqrtf(msg);
    const float* wnp = retw + h * 128 + 4 * fq;
#pragma unroll
    for (int et = 0; et < 8; ++et) { const f32x4 wn = *(const f32x4*)(wnp + 16 * et); const u32x2 gv = LD8(goff + 32 * et);
        u32x2 ov; ov.x = pk2(o[et][0] * sc * wn[0] * siluf_(bflo(gv.x)), o[et][1] * sc * wn[1] * siluf_(bfhi(gv.x))); ov.y = pk2(o[et][2] * sc * wn[2] * siluf_(bflo(gv.y)), o[et][3] * sc * wn[3] * siluf_(bfhi(gv.y)));
        *(u32x2*)(ws + moff + 32 * et) = ov; }
}
constexpr int RT_PITCH = 272, RT_TILE = 128 * RT_PITCH;
__device__ __forceinline__ void rt_load(u32x4 (&r)[4], const unsigned char* ws, unsigned goff, unsigned gpitch, int tid) {
#pragma unroll
    for (int i = 0; i < 4; ++i) { const int c = tid + 512 * i; r[i] = *(const u32x4*)(ws + goff + (unsigned)(c >> 4) * gpitch + (unsigned)(c & 15) * 16u); }
}
__device__ __forceinline__ void rt_store(const u32x4 (&r)[4], LAS unsigned char* t, int tid) {
#pragma unroll
    for (int i = 0; i < 4; ++i) { const int c = tid + 512 * i; *(LAS u32x4*)(t + (c >> 4) * RT_PITCH + (c & 15) * 16) = r[i]; }
}
#define LF16(t, row, col) (*(const LAS bf16x8*)((t) + (row) * RT_PITCH + (col) * 2))
#define LF8(t, row, col) (*(const LAS u32x2*)((t) + (row) * RT_PITCH + (col) * 2))
__device__ __forceinline__ void r1_item_lds(int item, unsigned char* ws, LAS unsigned char* lds, int w, int lane, int tid) {
    const int bh = item >> 6, n = item & 63, b = bh >> 2, h = bh & 3, fr = lane & 15, fq = lane >> 4; const int tok0 = b * 8192 + n * 128;
    LAS unsigned char* Vs = lds; LAS unsigned char* Ks = lds + RT_TILE;
    { u32x4 rv[4], rk[4];
      rt_load(rv, ws, (unsigned)WS_VT + (unsigned)((h * 128 * NT + tok0) * 2), NT * 2, tid); rt_load(rk, ws, (unsigned)WS_KWT + (unsigned)((h * 128 * NT + tok0) * 2), NT * 2, tid);
      rt_store(rv, Vs, tid); rt_store(rk, Ks, tid); }
    __syncthreads();
    bf16x8 vf[4];
#pragma unroll
    for (int ks = 0; ks < 4; ++ks) vf[ks] = LF16(Vs, 16 * w + fr, 32 * ks + 8 * fq);
    const unsigned ooff = (unsigned)WS_KVT + (unsigned)((((bh * 64 + n) * 128 + 16 * w + 4 * fq) * 128 + fr) * 4);
#pragma unroll
    for (int dt = 0; dt < 8; ++dt) { f32x4 acc = (f32x4){0.f, 0.f, 0.f, 0.f};
#pragma unroll
        for (int ks = 0; ks < 4; ++ks) acc = mfma16(vf[ks], LF16(Ks, 16 * dt + fr, 32 * ks + 8 * fq), acc);
#pragma unroll
        for (int jj = 0; jj < 4; ++jj) *(float*)(ws + ooff + (unsigned)((jj * 128 + 16 * dt) * 4)) = acc[jj]; }
    __syncthreads();
}
struct R3Regs { u32x4 rq[4], rk[4], rv[4], rs[4]; };
__device__ __forceinline__ void r3_loads(int item, const unsigned char* ws, R3Regs& R, int tid) {
    const int bh = item >> 6, n = item & 63, b = bh >> 2, h = bh & 3; const int tok0 = b * 8192 + n * 128;
    rt_load(R.rq, ws, (unsigned)WS_Q + (unsigned)((tok0 * 512 + h * 128) * 2), 1024, tid); rt_load(R.rk, ws, (unsigned)WS_K + (unsigned)((tok0 * 512 + h * 128) * 2), 1024, tid);
    rt_load(R.rv, ws, (unsigned)WS_VT + (unsigned)((h * 128 * NT + tok0) * 2), NT * 2, tid); rt_load(R.rs, ws, (unsigned)WS_SPT + (unsigned)((bh * 64 + n) * 16384 * 2), 256, tid);
}
__device__ __forceinline__ void r3_item_pipe(int item, int nxt, R3Regs& R, unsigned char* ws, const float* retw, LAS unsigned char* lds, int w, int lane, int tid) {
    const int bh = item >> 6, n = item & 63, b = bh >> 2, h = bh & 3, fr = lane & 15, fq = lane >> 4; const int tok0 = b * 8192 + n * 128, irow = tok0 + 16 * w + fr;
    const float l2g = log2gamma(h);
    LAS unsigned char* Qs = lds; LAS unsigned char* Ks = lds + RT_TILE; LAS unsigned char* Vs = lds + 2 * RT_TILE; LAS unsigned char* Ss = lds + 3 * RT_TILE;
    rt_store(R.rq, Qs, tid); rt_store(R.rk, Ks, tid); rt_store(R.rv, Vs, tid); rt_store(R.rs, Ss, tid);
    if (nxt >= 0) r3_loads(nxt, ws, R, tid);
    const unsigned goff = (unsigned)WS_G + (unsigned)((irow * 512 + h * 128 + 4 * fq) * 2);
    const unsigned moff = (unsigned)WS_MIX + (unsigned)((irow * 1024 + h * 128 + 4 * fq) * 2);
    u32x2 gv[8];
#pragma unroll
    for (int et = 0; et < 8; ++et) gv[et] = *(const u32x2*)(ws + goff + 32 * et);
    __syncthreads();
    bf16x8 qf[4];
#pragma unroll
    for (int ks = 0; ks < 4; ++ks) qf[ks] = LF16(Qs, 16 * w + fr, 32 * ks + 8 * fq);
    f32x4 s[8];
#pragma unroll
    for (int jt = 0; jt < 8; ++jt) { s[jt] = (f32x4){0.f, 0.f, 0.f, 0.f};
        if (jt <= w) {
#pragma unroll
            for (int ks = 0; ks < 4; ++ks) s[jt] = mfma16(LF16(Ks, 16 * jt + fr, 32 * ks + 8 * fq), qf[ks], s[jt]);
#pragma unroll
            for (int jj = 0; jj < 4; ++jj) { const int dd = 16 * (w - jt) + fr - 4 * fq - jj; s[jt][jj] = dd >= 0 ? s[jt][jj] * exp2f(l2g * (float)dd) : 0.f; } } }
    f32x4 o[8];
#pragma unroll
    for (int et = 0; et < 8; ++et) o[et] = (f32x4){0.f, 0.f, 0.f, 0.f};
#pragma unroll
    for (int kp = 0; kp < 4; ++kp) if (2 * kp <= w) { const bf16x8 sf = __builtin_bit_cast(bf16x8, pk8(s[2 * kp], s[2 * kp + 1]));
#pragma unroll
        for (int et = 0; et < 8; ++et) { const u32x2 v0 = LF8(Vs, 16 * et + fr, 32 * kp + 4 * fq), v1 = LF8(Vs, 16 * et + fr, 32 * kp + 16 + 4 * fq);
            const u32x4 vv = (u32x4){v0.x, v0.y, v1.x, v1.y}; o[et] = mfma16(__builtin_bit_cast(bf16x8, vv), sf, o[et]); } }
    const float wq = exp2f(l2g * (float)(16 * w + fr + 1)); float s1 = 0.f;
#pragma unroll
    for (int et = 0; et < 8; ++et) { f32x4 oc = (f32x4){0.f, 0.f, 0.f, 0.f};
#pragma unroll
        for (int ks = 0; ks < 4; ++ks) oc = mfma16(LF16(Ss, 16 * et + fr, 32 * ks + 8 * fq), qf[ks], oc);
        o[et] = o[et] + wq * oc; s1 += sum4(o[et]); }
    s1 += __shfl_xor(s1, 16); s1 += __shfl_xor(s1, 32); const float mean = s1 * (1.0f / 128.0f); float s2 = 0.f;
#pragma unroll
    for (int et = 0; et < 8; ++et) { o[et] = o[et] - mean; s2 += sumsq4(o[et]); }
    s2 += __shfl_xor(s2, 16); s2 += __shfl_xor(s2, 32);
    const float sc = 1.0f / sqrtf(s2 * (1.0f / 128.0f) + EPS);
    const float* wnp = retw + h * 128 + 4 * fq;
#pragma unroll
    for (int et = 0; et < 8; ++et) { const f32x4 wn = *(const f32x4*)(wnp + 16 * et);
        u32x2 ov; ov.x = pk2(o[et][0] * sc * wn[0] * siluf_(bflo(gv[et].x)), o[et][1] * sc * wn[1] * siluf_(bfhi(gv[et].x))); ov.y = pk2(o[et][2] * sc * wn[2] * siluf_(bflo(gv[et].y)), o[et][3] * sc * wn[3] * siluf_(bfhi(gv[et].y)));
        *(u32x2*)(ws + moff + 32 * et) = ov; }
    __syncthreads();
}

#define XB_TMO      128
#define XB_XCNT(j)  (256  + 64 * (j))
#define XB_XSUB(j)  (1280 + 64 * (j))
#define XB_XGEN(j)  (2304 + 64 * (j))
#define XB_TOP      3328
#define XB_TOPGEN   3392
#define XCD_BAR_WORDS 3456
#define XB_SPIN_CAP (1u << 18)

__device__ __forceinline__ unsigned xb_ld(unsigned* p)              { return __hip_atomic_load(p, __ATOMIC_RELAXED, __HIP_MEMORY_SCOPE_AGENT); }
__device__ __forceinline__ unsigned xb_add(unsigned* p, unsigned v) { return __hip_atomic_fetch_add(p, v, __ATOMIC_RELAXED, __HIP_MEMORY_SCOPE_AGENT); }
__device__ __forceinline__ unsigned xb_xcc_id() { return (unsigned)__builtin_amdgcn_s_getreg((3 << 11) | 20) & 0xFu; }
#define XB_SPIN(cond, bar) do { unsigned _sp = 0; while (cond) { __builtin_amdgcn_s_sleep(1); \
    if ((++_sp & 255u) == 0u) { if (xb_ld(&(bar)[XB_TMO])) break; if (_sp > XB_SPIN_CAP) { atomicAdd(&(bar)[XB_TMO], 1u); break; } } } } while (0)

struct XcdBarrier {
    unsigned* bar; unsigned x;
    volatile LAS unsigned* st;
};

__device__ __forceinline__ XcdBarrier xcd_barrier_post(unsigned* bar, volatile LAS unsigned* st) {
    XcdBarrier b; b.bar = bar; b.x = xb_xcc_id(); b.st = st;
    if (threadIdx.x == 0) (void)xb_add(&bar[XB_XCNT(b.x)], 1u);
    return b;
}
__device__ __forceinline__ void xcd_barrier_complete(unsigned* bar, unsigned x, unsigned& nloc, unsigned& nx) {
    const unsigned G = gridDim.x * gridDim.y * gridDim.z;
    unsigned sum, cnt, mine, sp = 0u;
    for (;;) {
        sum = 0u; cnt = 0u; mine = 0u;
#pragma unroll
        for (unsigned j = 0; j < 16; ++j) { const unsigned c = xb_ld(&bar[XB_XCNT(j)]); sum += c; cnt += (c > 0u) ? 1u : 0u; mine = (j == x) ? c : mine; }
        if (sum == G) break;
        __builtin_amdgcn_s_sleep(1);
        if ((++sp & 255u) == 0u) { if (xb_ld(&bar[XB_TMO])) break; if (sp > XB_SPIN_CAP) { atomicAdd(&bar[XB_TMO], 1u); break; } }
    }
    nloc = mine > 0u ? mine : 1u; nx = cnt > 0u ? cnt : 1u;
}

__device__ __forceinline__ void xcd_barrier(const XcdBarrier& b) {
    asm volatile("s_waitcnt vmcnt(0)" ::: "memory");
    __syncthreads();
    if (threadIdx.x == 0) {
        unsigned* bar = b.bar;
        __builtin_amdgcn_s_waitcnt(0);
        unsigned nloc = b.st[0], nx = b.st[1];
        if (nloc == 0u) { xcd_barrier_complete(bar, b.x, nloc, nx); b.st[0] = nloc; b.st[1] = nx; }
        const unsigned old = xb_add(&bar[XB_XSUB(b.x)], 1u);
        const unsigned gen = old / nloc;
        if (old + 1u == (gen + 1u) * nloc) {
            __builtin_amdgcn_fence(__ATOMIC_RELEASE, "agent");
            asm volatile("s_waitcnt vmcnt(0)" ::: "memory");
            const unsigned og = xb_add(&bar[XB_TOP], 1u);
            const unsigned tg = og / nx;
            if (og + 1u == (tg + 1u) * nx) xb_add(&bar[XB_TOPGEN], 1u);
            else XB_SPIN(xb_ld(&bar[XB_TOPGEN]) == tg, bar);
            __builtin_amdgcn_fence(__ATOMIC_ACQUIRE, "agent");
            xb_add(&bar[XB_XGEN(b.x)], 1u);
            asm volatile("s_waitcnt vmcnt(0)" ::: "memory");
        } else {
            XB_SPIN(xb_ld(&bar[XB_XGEN(b.x)]) == gen, bar);
            __builtin_amdgcn_fence(__ATOMIC_ACQUIRE, "agent");
            asm volatile("s_waitcnt vmcnt(0)" ::: "memory");
        }
    }
    __syncthreads();
}


#define GEMM_PHASE(EpiT, SchedT, g, S, E) pg8::gemm_phase<EpiT, SchedT, true, true>((PG8_LAS unsigned char*)lds, g, S, E)

__global__ void __launch_bounds__(NTHR, 2) hymba_fwd(Args args) {
    extern __shared__ __attribute__((aligned(16))) unsigned char lds_raw[];
    LAS unsigned char* lds = (LAS unsigned char*)lds_raw;
    cg::grid_group grid = cg::this_grid();
    const int tid = threadIdx.x, lane = tid & 63, wave = __builtin_amdgcn_readfirstlane(tid >> 6);
    const int G = gridDim.x, bx = blockIdx.x, vcu = (G % 8 == 0) ? (bx % 8) * (G / 8) + bx / 8 : bx;
    const int gw = vcu * NWAVES + wave, NGW = G * NWAVES, swid = wave * G + vcu;
    const int gtid = vcu * NTHR + tid, NTH = G * NTHR;
    volatile LAS unsigned* xst = (volatile LAS unsigned*)(lds + LDS_BYTES - 16);
    if (tid == 0) { xst[0] = 0u; xst[1] = 0u; }
    __syncthreads();
    XcdBarrier xbar = xcd_barrier_post((unsigned*)(args.ws + WS_BAR), xst);
#ifndef PROBE_A
#define PROBE_A -1
#define PROBE_B -1
#endif
#ifndef PROBE_BX
#define PROBE_BX 0
#endif
    LAS unsigned long long* TS = (LAS unsigned long long*)(lds + LDS_BYTES - 160);
#define STAMP(i) do { if (PROBE_A >= 0 && bx == PROBE_BX && tid == 0) TS[i] = __builtin_amdgcn_s_memrealtime(); } while (0)
    STAMP(0);
    typedef const __attribute__((address_space(4))) Args* KArgP;
#define KA() ({ KArgP _k = (KArgP)__builtin_amdgcn_kernarg_segment_ptr(); asm volatile("" : "+s"(_k)); _k; })
    const int lo = args.ph_lo, hi = args.ph_hi;
#ifndef PHASE_MASK
#define PHASE_MASK 0xffff
#endif
#define IN(k) (((PHASE_MASK >> (k)) & 1) && lo <= (k) && (k) < hi)
#ifndef REP_MASK
#define REP_MASK 0
#endif
#ifndef SYNC_REP
#define SYNC_REP 1
#endif
#define NREP(k) ((((REP_MASK) >> (k)) & 1) ? 2 : 1)
#define SEAM(k) do { if (IN(k) && IN((k) + 1)) { for (int sr = 0; sr < SYNC_REP; ++sr) { if ((k) == 0) grid.sync(); else xcd_barrier(xbar); } } } while (0)
#define SSQ1 ((float*)(ws + WS_SSQ1))
#define SSQ2 ((float*)(ws + WS_SSQ2))
#define SSQ3 ((float*)(ws + WS_SSQ3))
#define SSQG ((float*)(ws + WS_SSQG))
#define N1M ((bf16*)(ws + WS_N1M))
#define GUM ((float*)(ws + WS_GUM))
#define H1MF ((float*)(ws + WS_H1MF))
#define PM ((float*)(ws + WS_PM))
#define ST0 ((float*)(ws + WS_ST0))
#define ZM ((float*)(ws + WS_ZM))
#define A16 ((const f32x2*)(ws + WS_A16))
#define H1B ((bf16*)(ws + WS_H1B))
#define WMAIN ((bf16*)(ws + WS_WMAIN))
#define WKV ((bf16*)(ws + WS_WKV))
#define ROT ((f32x2*)(ws + WS_ROT))
#define ACT ((bf16*)(ws + WS_ACT))
#define Qb ((bf16*)(ws + WS_Q))
#define Kb ((bf16*)(ws + WS_K))
#define Gb ((bf16*)(ws + WS_G))
#define KWT ((bf16*)(ws + WS_KWT))
#define VT ((bf16*)(ws + WS_VT))
#define N1 ((bf16*)(ws + WS_N1))
#define UA ((bf16*)(ws + WS_UA))
#define MIX ((bf16*)(ws + WS_MIX))
#define Zb ((float*)(ws + WS_Z))
#define SPT ((bf16*)(ws + WS_SPT))
#define KVT ((float*)(ws + WS_KVT))
#define Yb ((bf16*)(ws + WS_Y))

    if (IN(0)) for (int rep = 0; rep < NREP(0); ++rep) {
        if (rep) __syncthreads();
        Args a0; { KArgP ka = KA(); for (int i = 0; i < 26; ++i) a0.in[i] = ka->in[i]; a0.out = ka->out; a0.ws = ka->ws; a0.ph_lo = 0; a0.ph_hi = 0; } const Args& args = a0; unsigned char* ws = a0.ws;
        for (int g = vcu; g < 32; g += G) ssm_mats(args, g, lds, tid);
        LAS float* scr = (LAS float*)(lds + wave * 17408);
        {
            const bool split = (G > 32); const bool worker = !split || vcu >= 32;
            const int ww = split ? gw - 32 * NWAVES : gw, WW = split ? NGW - 32 * NWAVES : NGW;
            const int wt = split ? gtid - 32 * NTHR : gtid, WTN = split ? NTH - 32 * NTHR : NTH;
            if (worker) {
                tr_run(args, 0, 12, ww, WW, scr, lane);
                for (int m = ww; m < NT; m += 4 * WW) {
                    if (m + 3 * WW < NT) rms_rows4_to_bf16(args.in[0] + (size_t)m * DM, (size_t)WW * DM, args.in[2], N1 + (size_t)m * DM, (size_t)WW * DM, lane);
                    else for (int q = 0; q < 4; ++q) if (m + q * WW < NT) rms_row_to_bf16(args.in[0] + (size_t)(m + q * WW) * DM, args.in[2], N1 + (size_t)(m + q * WW) * DM, lane);
                }
                if (ww < 16) rms_row_to_bf16(args.in[1] + (size_t)ww * DM, args.in[2], N1M + (size_t)ww * DM, lane);
                {   const int i = wt & 63; const double f = exp2(-(double)i * (13.287712379549449 / 64.0));
                    for (int idx = wt; idx < 8208 * 64; idx += WTN) { const int pos = idx >> 6; double ang = (double)pos * f; ang -= 6.283185307179586 * floor(ang * 0.15915494309189535);
                        float sn, cs; sincosf((float)ang, &sn, &cs); ROT[idx] = (f32x2){cs, sn}; } }
                for (int idx = wt; idx < NT; idx += WTN) { SSQ1[idx] = 0.f; SSQ2[idx] = 0.f; SSQ3[idx] = 0.f; SSQG[idx] = 0.f; }
                for (int idx = wt; idx < 16 * 1024; idx += WTN) H1MF[idx] = args.in[1][idx];
                for (int idx = wt; idx < 16 * 1536; idx += WTN) PM[idx] = 0.f;
            }
        }
    }
    STAMP(13);
    SEAM(0);
    STAMP(1);
    if (IN(1)) for (int rep = 0; rep < NREP(1); ++rep) {
        if (rep) __syncthreads();
        KArgP ka = KA(); unsigned char* ws = ka->ws;
        if (bx >= G / 2) skinny((const bf16*)(ws + WS_WGU1), DM, 352, 1, DM, wave * (G - G / 2) + (bx - G / 2), NWAVES * (G - G / 2), ALBf16{N1M, DM}, EPStore{GUM, 5632}, lane);
        pg8::Gemm g{N1, (const bf16*)(ws + WS_WGU1), DM, DM, DM}; pg8::StaticOrder S; S.init(NT, 5632, G, bx);
        EpiSwiGLU E{ACT, nullptr};
        GEMM_PHASE(EpiSwiGLU, pg8::StaticOrder, g, S, E);
    }
    SEAM(1);
    STAMP(2);
    if (IN(2)) for (int rep = 0; rep < NREP(2); ++rep) {
        if (rep) __syncthreads();
        KArgP ka = KA(); unsigned char* ws = ka->ws;
        skinny((const bf16*)(ws + WS_WD1), FF, 64, 22, FF, swid, NGW, ALSwiGLU{GUM}, EPAtomic{H1MF, 1024, 0.5f}, lane);
        pg8::Gemm g{ACT, (const bf16*)(ws + WS_WD1), FF, FF, FF}; pg8::StaticOrder S; S.init(NT, DM, G, bx);
        EpiRes<0> E{ka->in[0], ka->out, H1B, SSQ1, nullptr};
        GEMM_PHASE(EpiRes<0>, pg8::StaticOrder, g, S, E);
    }
    SEAM(2);
    STAMP(3);
    if (IN(3)) for (int rep = 0; rep < NREP(3); ++rep) {
        if (rep) __syncthreads();
        KArgP ka = KA(); unsigned char* ws = ka->ws;
        skinny(WMAIN + (size_t)512 * DM, DM, 32, 8, DM, swid, NGW, ALF32{H1MF, DM}, EPAtomic{PM, 1536, 1.0f}, lane);
        skinny(WKV + (size_t)512 * DM, DM, 32, 8, DM, (swid + NGW - 256) % NGW, NGW, ALF32{H1MF, DM}, EPAtomic{PM + 512, 1536, 1.0f}, lane);
        skinny(WMAIN + (size_t)1536 * DM, DM, 32, 8, DM, (swid + NGW - 512) % NGW, NGW, ALF32{H1MF, DM}, EPAtomic{PM + 1024, 1536, 1.0f}, lane);
        pg8::Gemm g{H1B, WMAIN, DM, DM, DM}; P3Order S{G, vcu};
        EpiInProj E{SSQ1, ROT, Qb, Kb, Gb, UA, KWT, VT};
        GEMM_PHASE(EpiInProj, P3Order, g, S, E);
    }
    SEAM(3);
    STAMP(4);
    if (IN(4)) for (int rep = 0; rep < NREP(4); ++rep) {
        if (rep) __syncthreads();
        KArgP ka = KA(); unsigned char* ws = ka->ws;
        const int nhalf = G / 2;
        if (vcu >= nhalf) {
            LAS float* rs1 = (LAS float*)lds;
            for (int r = wave * 2; r < wave * 2 + 2; ++r) { float s = 0.f; for (int c = lane; c < DM; c += 64) { const float v = H1MF[r * DM + c]; s += v * v; } s = wave_sum(s); if (lane == 0) rs1[r] = 1.0f / sqrtf(s * (1.0f / 1024.0f) + EPS); }
            __syncthreads();
            const int sb = vcu - nhalf, nsb = G - nhalf;
            for (int o = sb * NTHR + tid; o < 65536; o += nsb * NTHR) { const int h = o >> 14, e = (o >> 7) & 127, d = o & 127, i = d & 63; const float l2g = log2gamma(h); float acc = 0.f;
#pragma unroll
                for (int j = 0; j < 16; ++j) { const float r = rs1[j]; const float x1 = PM[j * 1536 + 256 * (h >> 1) + 64 * (h & 1) + i], x2 = PM[j * 1536 + 256 * (h >> 1) + 64 * (h & 1) + i + 128]; const f32x2 cs = ROT[j * 64 + i];
                    const float kd = (d < 64) ? (x1 * cs.x - x2 * cs.y) : (x1 * cs.y + x2 * cs.x); acc += exp2f(l2g * (float)(15 - j)) * kd * PM[j * 1536 + 512 + h * 128 + e] * (r * r * 0.08838834764831845f); }
                ST0[o] = acc; }
            for (int o = sb * NWAVES + wave; o < 4096; o += nsb * NWAVES) {
                const int g = o >> 7, r = o & 127; const bf16* wz = (const bf16*)(ws + WS_WZ) + (size_t)(g * 256 + r) * 256; float acc = 0.f;
#pragma unroll
                for (int k = 0; k < 4; ++k) { const int c = lane + 64 * k; acc += bf2f(wz[c]) * PM[(c >> 4) * 1536 + 1024 + g * 16 + (c & 15)] * rs1[c >> 4]; }
                acc = wave_sum(acc); if (lane == 0) ZM[o] = acc; }
            __syncthreads();
        }
        if (G == 256) { if (vcu >= 128) { for (int k2 = 0; k2 < 3; ++k2) r1_item_lds((vcu - 128) + 128 * k2, ws, lds, wave, lane, tid); } else r1_item_lds(384 + vcu, ws, lds, wave, lane, tid); }
        else for (int it = vcu; it < 512; it += G) r1_item_lds(it, ws, lds, wave, lane, tid);
        __syncthreads();
        int kdyn = 256; asm volatile("" : "+s"(kdyn)); pg8::Gemm g{UA, (const bf16*)(ws + WS_WZ), kdyn, 384, 256}; GroupOrder S{G, vcu};
        EpiZ E{Zb};
        GEMM_PHASE(EpiZ, GroupOrder, g, S, E);
    }
    SEAM(4);
    STAMP(5);
    if (IN(6)) for (int rep = 0; rep < NREP(6); ++rep) {
        if (rep) __syncthreads();
        KArgP ka = KA(); unsigned char* ws = ka->ws;
        if (rep == 0) {
        for (int L = vcu; L < 128; L += G) {
            const int g = L >> 2, rt = L & 3, b = rt >> 1, half = rt & 1, n = lane; const f32x2 a16 = A16[g * 64 + n];
            LAS f32x2* T = (LAS f32x2*)lds;
            const float* zb = Zb + ((size_t)g * 1024 + b * 512) * 128 + n;
            float zr[32], zi[32];
            for (int sg = wave; sg < 8 + 8 * half; sg += 8) { f32x2 X = (f32x2){0.f, 0.f};
#pragma unroll
                for (int c = 0; c < 32; ++c) { zr[c] = zb[(size_t)(sg * 32 + c) * 128]; zi[c] = zb[(size_t)(sg * 32 + c) * 128 + 64]; }
#pragma unroll
                for (int c = 0; c < 32; ++c) { const f32x2 t = cmul(a16, X); X = (f32x2){t.x + zr[c], t.y + zi[c]}; }
                T[sg * 64 + n] = X; }
            __syncthreads();
            f32x2 a512 = a16;
#pragma unroll
            for (int q = 0; q < 5; ++q) a512 = cmul(a512, a512);
            { const int sg = half * 8 + wave; f32x2 X = (f32x2){ZM[g * 128 + n], ZM[g * 128 + 64 + n]};
                for (int s2 = 0; s2 < sg; ++s2) { const f32x2 t = cmul(a512, X), tt = T[s2 * 64 + n]; X = (f32x2){t.x + tt.x, t.y + tt.y}; }
                bf16* xo = UA + ((size_t)g * 1024 + b * 512 + sg * 32) * 384 + 256 + n;
                {
#pragma unroll
                    for (int c = 0; c < 32; ++c) { xo[(size_t)c * 384] = (bf16)(pk2(X.x, 0.f) & 0xffffu); xo[(size_t)c * 384 + 64] = (bf16)(pk2(X.y, 0.f) & 0xffffu);
                        const f32x2 t = cmul(a16, X); X = (f32x2){t.x + zr[c], t.y + zi[c]}; } } }
            asm volatile("s_waitcnt vmcnt(0)" ::: "memory");
            __syncthreads();
        }
        {
            const bool all = (G <= 128); const int t0 = all ? gtid : gtid - 128 * NTHR, tn = all ? NTH : NTH - 128 * NTHR;
            if (all || vcu >= 128)
            for (int idx = t0; idx < 8 * 16384; idx += tn) { const int bh = idx >> 14, ed = idx & 16383, h = bh & 3; const float gch = exp2f(128.0f * log2gamma(h)); float S = ST0[h * 16384 + ed];
                const float* kv = KVT + (size_t)bh * 64 * 16384 + ed; bf16* sp = SPT + (size_t)bh * 64 * 16384 + ed;
                { float v[64];
#pragma unroll
                    for (int c = 0; c < 64; ++c) v[c] = kv[(size_t)c * 16384];
#pragma unroll
                    for (int c = 0; c < 64; ++c) { sp[(size_t)c * 16384] = (bf16)(pk2(S, 0.f) & 0xffffu); S = gch * S + v[c]; } } }
        }
        }
        STAMP(14);
        if (rep == 0) {
            Args a0; { for (int i = 0; i < 26; ++i) a0.in[i] = ka->in[i]; a0.out = nullptr; a0.ws = ws; a0.ph_lo = 0; a0.ph_hi = 0; }
            LAS float* scr = (LAS float*)(lds + wave * 17408); const int tw0 = gw, tnw = NGW;
            if (G == 256) {
                constexpr int NSPLIT = 1267;
                if (vcu >= 128) tr_run(a0, 12, NJOBS, gw - 128 * NWAVES, 128 * NWAVES, scr, lane, NSPLIT);
                else tr_run(a0, 12, NJOBS, NSPLIT + gw, 128 * NWAVES, scr, lane);
            } else tr_run(a0, 12, NJOBS, tw0, tnw, scr, lane);
            __syncthreads();
        }
        STAMP(15);
        int kdyn = 384; asm volatile("" : "+s"(kdyn)); pg8::Gemm g{UA, (const bf16*)(ws + WS_WY), kdyn, 384, 384}; GroupOrder S{G, vcu};
        EpiY E{UA, ka->in[16], Yb};
        GEMM_PHASE(EpiY, GroupOrder, g, S, E);
    }
    SEAM(6);
    STAMP(7);
    if (IN(7)) for (int rep = 0; rep < NREP(7); ++rep) {
        if (rep) __syncthreads();
        KArgP ka = KA(); unsigned char* ws = ka->ws;
        if (rep == 0) {
            R3Regs R;
            if (G == 256) {
                if (bx >= 128) { const int i0 = bx - 128; r3_loads(i0, ws, R, tid);
                    r3_item_pipe(i0, i0 + 128, R, ws, ka->in[8], lds, wave, lane, tid); r3_item_pipe(i0 + 128, i0 + 256, R, ws, ka->in[8], lds, wave, lane, tid); r3_item_pipe(i0 + 256, -1, R, ws, ka->in[8], lds, wave, lane, tid); }
                else { r3_loads(384 + bx, ws, R, tid); r3_item_pipe(384 + bx, -1, R, ws, ka->in[8], lds, wave, lane, tid); }
            } else for (int it = vcu; it < 512; it += G) { r3_loads(it, ws, R, tid); r3_item_pipe(it, -1, R, ws, ka->in[8], lds, wave, lane, tid); }
        }
        pg8::Gemm g{Yb, (const bf16*)(ws + WS_WGLU), 512, 512, 512}; pg8::StaticOrder S; S.init(NT, 512, G, bx);
        EpiGLU E{Yb, ka->in[18], MIX, SSQG};
        GEMM_PHASE(EpiGLU, pg8::StaticOrder, g, S, E);
    }
    SEAM(8);
    STAMP(9);
    if (IN(9)) for (int rep = 0; rep < NREP(9); ++rep) {
        if (rep) __syncthreads();
        KArgP ka = KA(); unsigned char* ws = ka->ws; float* outp = ka->out;
        pg8::Gemm g{MIX, (const bf16*)(ws + WS_WOUT), DM, DM, DM}; pg8::StaticOrder S; S.init(NT, DM, G, bx);
        EpiRes<1> E{outp, outp, H1B, SSQ2, SSQG};
        GEMM_PHASE(EpiRes<1>, pg8::StaticOrder, g, S, E);
    }
    SEAM(9);
    STAMP(10);
    if (IN(10)) for (int rep = 0; rep < NREP(10); ++rep) {
        if (rep) __syncthreads();
        KArgP ka = KA(); unsigned char* ws = ka->ws;
        pg8::Gemm g{H1B, (const bf16*)(ws + WS_WGU2), DM, DM, DM}; pg8::StaticOrder S; S.init(NT, 5632, G, bx);
        EpiSwiGLU E{ACT, SSQ2};
        GEMM_PHASE(EpiSwiGLU, pg8::StaticOrder, g, S, E);
    }
    SEAM(10);
    STAMP(11);
    if (IN(11)) for (int rep = 0; rep < NREP(11); ++rep) {
        if (rep) __syncthreads();
        KArgP ka = KA(); unsigned char* ws = ka->ws; float* outp = ka->out;
        pg8::Gemm g{ACT, (const bf16*)(ws + WS_WD2), FF, FF, FF}; pg8::StaticOrder S; S.init(NT, DM, G, bx);
        EpiFinal E{outp, outp, SSQ3, (unsigned*)(ws + WS_BAR + 16 * KiB), ka->in[25]};
        GEMM_PHASE(EpiFinal, pg8::StaticOrder, g, S, E);
    }
    STAMP(12);
    if (PROBE_A >= 0 && bx == PROBE_BX && tid == 0) {
        const unsigned long long d = TS[PROBE_B] - TS[PROBE_A], t0 = __builtin_amdgcn_s_memrealtime();
        while (__builtin_amdgcn_s_memrealtime() - t0 < 4ull * d) __builtin_amdgcn_s_sleep(8);
    }
#undef IN
#undef SEAM
}

#ifndef MK_PER_PHASE
#define MK_PER_PHASE 0
#endif
constexpr int NPHASES = 13;
extern "C" void kernel_launch(void* const* d_in, const int* in_sizes, int n_in, void* d_out, int out_size, void* d_ws, size_t ws_size, hipStream_t stream) {
    static int grid = 0;
    if (grid == 0) {
        if (n_in != 26 || out_size != NT * DM || ws_size < WS_END) { fprintf(stderr, "kernel_launch: unexpected shapes (n_in %d, out %d, ws %zu)\n", n_in, out_size, ws_size); grid = -1; return; }
        int dev = 0, cus = 0, per_cu = 0;
        hipGetDevice(&dev); hipDeviceGetAttribute(&cus, hipDeviceAttributeMultiprocessorCount, dev);
        if (hipFuncSetAttribute((const void*)hymba_fwd, hipFuncAttributeMaxDynamicSharedMemorySize, LDS_BYTES) != hipSuccess) { fprintf(stderr, "kernel_launch: hipFuncSetAttribute failed\n"); grid = -1; return; }
        if (hipOccupancyMaxActiveBlocksPerMultiprocessor(&per_cu, (const void*)hymba_fwd, NTHR, LDS_BYTES) != hipSuccess || per_cu < 1) { fprintf(stderr, "kernel_launch: occupancy query failed (%d)\n", per_cu); (void)hipGetLastError(); per_cu = 1; }
        grid = cus * 1;
        fprintf(stderr, "kernel_launch: grid %d (per_cu %d), ws %zu\n", grid, per_cu, ws_size);
    }
    if (grid < 0) return;
    Args a{};
    for (int i = 0; i < 26; ++i) a.in[i] = (const float*)d_in[i];
    a.out = (float*)d_out; a.ws = (unsigned char*)d_ws;
    if (hipMemsetAsync((char*)d_ws + WS_BAR, 0, BAR_BYTES, stream) != hipSuccess) { fprintf(stderr, "kernel_launch: memset of barrier words failed\n"); return; }
#if MK_PER_PHASE
    for (int p = 0; p < NPHASES; ++p) { a.ph_lo = p; a.ph_hi = p + 1; hipLaunchKernelGGL(hymba_fwd, dim3(grid), dim3(NTHR), LDS_BYTES, stream, a); }
#else
    a.ph_lo = 0; a.ph_hi = NPHASES;
    void* kargs[] = {&a};
    hipError_t e = hipLaunchCooperativeKernel((const void*)hymba_fwd, dim3(grid), dim3(NTHR), kargs, LDS_BYTES, stream);
    if (e != hipSuccess) fprintf(stderr, "kernel_launch: cooperative launch failed: %s (grid %d)\n", hipGetErrorString(e), grid);
#endif
}
```

```cpp
#include <hip/hip_runtime.h>
#include <hip/hip_cooperative_groups.h>
#include <cstdio>
#include <cstdint>
namespace cg = cooperative_groups;
namespace pg8 {
#define PG8_LAS __attribute__((address_space(3)))
typedef unsigned short bf16_t;
typedef short bf16x8 __attribute__((ext_vector_type(8)));
typedef float f32x4 __attribute__((ext_vector_type(4)));
typedef unsigned u32x4 __attribute__((ext_vector_type(4)));
constexpr int BM = 256, BK = 64, HALF = 128, HTB = HALF * BK * 2  , STAGE_BYTES = 8 * HTB, NXCD = 8, WGM = 8;

__host__ __device__ __forceinline__ int lds_byte(int r, int c) { const int st = (r >> 4) * 2 + (c >> 5), rr = r & 15, cc = c & 31, ob = rr * 64 + cc * 2; return st * 1024 + (ob ^ (((ob >> 9) & 1) << 5)); }
__host__ __device__ __forceinline__ void stage_rc(int b, int& R, int& C) { const int st = b / 1024, sb = b % 1024, swz = sb ^ (((sb >> 9) & 1) << 5); R = (st >> 1) * 16 + swz / 64; C = (st & 1) * 32 + (swz % 64) / 2; }
__host__ __device__ __forceinline__ int perm32(int rho) { const int n = rho >> 4, i = rho & 15; return 8 * (i >> 2) + 4 * n + (i & 3); }

struct Unit { int pm, pn; };
struct Gemm { const bf16_t* A; const bf16_t* Bt; int K, lda, ldb; };

struct StaticOrder {
    int nM, nN, nwg, G, c;
    __host__ __device__ void init(int M, int N, int G_, int c_) { nM = M / BM; nN = N / BM; nwg = nM * nN; G = G_; c = c_; }
    __host__ __device__ bool next(int i, Unit& u) const {
        const long L = (long)i * G + c; if (L >= nwg) return false;
        int wgid = (int)L; { const int q = nwg / NXCD, r = nwg % NXCD, xcd = wgid % NXCD, off = wgid / NXCD; wgid = (xcd < r ? xcd * (q + 1) : r * (q + 1) + (xcd - r) * q) + off; }
        const int nig = WGM * nN, gid = wgid / nig, fm = gid * WGM, gsz = (nM - fm) < WGM ? (nM - fm) : WGM;
        u.pm = fm + ((wgid % nig) % gsz); u.pn = (wgid % nig) / gsz; return true;
    }
    __device__ __forceinline__ void a_ready(const Unit&) const {}
    __device__ __forceinline__ void done(const Unit&) const {}
};

__device__ __forceinline__ unsigned cvt_pk_bf16(float lo, float hi) { unsigned r; asm volatile("v_cvt_pk_bf16_f32 %0, %1, %2" : "=v"(r) : "v"(lo), "v"(hi)); return r; }
template <class Epi, class Sched, bool ALIGN_EPI = false, bool SP2 = false>
__device__ __forceinline__ void gemm_phase(PG8_LAS unsigned char* lds, const Gemm g, const Sched& S, const Epi& E) {
    const int tid = threadIdx.x, wid = __builtin_amdgcn_readfirstlane(tid >> 6), lane = tid & 63, wr = wid >> 2, wc = wid & 3, fr = lane & 15, fq = lane >> 4;
    const int K = g.K, nt = K / BK;
    unsigned voffA[2], voffB[2];
#pragma unroll
    for (int i = 0; i < 2; ++i) { int R, C; stage_rc(tid * 16 + i * 8192, R, C); const int Rb = Epi::PERM ? ((R & ~31) + perm32(R & 31)) : R;
        voffA[i] = (unsigned)(R * g.lda + C) * 2u; voffB[i] = (unsigned)(Rb * g.ldb + C) * 2u; }
    const size_t kstep = (size_t)(BK * 2);
    const size_t hstepA = (size_t)HALF * g.lda * 2, hstepB = (size_t)HALF * g.ldb * 2;
    const size_t tstepA = 2 * hstepA, tstepB = 2 * hstepB;
    const unsigned ldsw = (unsigned)wid * 1024u;
    const int aoff = lds_byte(wr * 64 + fr, fq * 8), boff = lds_byte(wc * 32 + fr, fq * 8);
#define PG8_SA(b, h) (((b) * 2 + (h)) * HTB)
#define PG8_SB(b, h) ((4 + (b) * 2 + (h)) * HTB)
#define PG8_STAGE(bufoff, gbase, voff) do { _Pragma("unroll") for (int _i = 0; _i < 2; ++_i) \
        __builtin_amdgcn_global_load_lds((const unsigned*)((const char*)(gbase) + (voff)[_i]), (PG8_LAS unsigned*)(lds + (bufoff) + ldsw + _i * 8192), 16, 0, 0); } while (0)
#define PG8_LDA(dst, b, h) do { _Pragma("unroll") for (int m = 0; m < 4; ++m) _Pragma("unroll") for (int k = 0; k < 2; ++k) dst[m][k] = *(const PG8_LAS bf16x8*)(lds + PG8_SA(b, h) + aoff + m * 2048 + k * 1024); } while (0)
#define PG8_LDB(dst, b, h) do { _Pragma("unroll") for (int n = 0; n < 2; ++n) _Pragma("unroll") for (int k = 0; k < 2; ++k) dst[n][k] = *(const PG8_LAS bf16x8*)(lds + PG8_SB(b, h) + boff + n * 2048 + k * 1024); } while (0)
#define PG8_MMA(ai, bj, At, Bt) do { __builtin_amdgcn_s_setprio(1); _Pragma("unroll") for (int m = 0; m < 4; ++m) _Pragma("unroll") for (int n = 0; n < 2; ++n) _Pragma("unroll") for (int k = 0; k < 2; ++k) \
        acc[ai][bj][m][n] = __builtin_amdgcn_mfma_f32_16x16x32_bf16(Bt[n][k], At[m][k], acc[ai][bj][m][n], 0, 0, 0); __builtin_amdgcn_s_setprio(0); } while (0)
#define PG8_WAIT_V(n) asm volatile("s_waitcnt vmcnt(" #n ")" ::: "memory")
#define PG8_WAIT_L(n) asm volatile("s_waitcnt lgkmcnt(" #n ")" ::: "memory")
#define PG8_BAR __builtin_amdgcn_s_barrier()
#define PG8_SCHED __builtin_amdgcn_sched_barrier(0)
    Unit cur, nxt; int ui = 0;
    if (!S.next(0, cur)) return;
    f32x4 acc[2][2][4][2];
#pragma unroll
    for (int a = 0; a < 2; ++a)
#pragma unroll
        for (int b = 0; b < 2; ++b)
#pragma unroll
            for (int m = 0; m < 4; ++m)
#pragma unroll
                for (int n = 0; n < 2; ++n) acc[a][b][m][n] = (f32x4){0.f, 0.f, 0.f, 0.f};
    bf16x8 At[4][2], B0[2][2], B1[2][2];
    const char* cA = (const char*)g.A + (size_t)cur.pm * tstepA; const char* cB = (const char*)g.Bt + (size_t)cur.pn * tstepB;
    S.a_ready(cur);
    if constexpr (SP2) {
        PG8_STAGE(PG8_SB(0, 0), cB, voffB); PG8_STAGE(PG8_SB(0, 1), cB + hstepB, voffB); PG8_STAGE(PG8_SA(0, 0), cA, voffA); PG8_STAGE(PG8_SA(0, 1), cA + hstepA, voffA);
        if (wr == 1) PG8_BAR;
        PG8_WAIT_V(2); PG8_BAR;
        PG8_STAGE(PG8_SB(1, 0), cB + kstep, voffB); PG8_STAGE(PG8_SA(1, 0), cA + kstep, voffA); PG8_STAGE(PG8_SB(1, 1), cB + hstepB + kstep, voffB);
        PG8_WAIT_V(6); PG8_BAR;
    } else {
        PG8_STAGE(PG8_SB(0, 0), cB, voffB); PG8_STAGE(PG8_SA(0, 0), cA, voffA); PG8_STAGE(PG8_SB(0, 1), cB + hstepB, voffB); PG8_STAGE(PG8_SA(0, 1), cA + hstepA, voffA);
        if (wr == 1) PG8_BAR;
        PG8_WAIT_V(4); PG8_BAR;
        PG8_STAGE(PG8_SB(1, 0), cB + kstep, voffB); PG8_STAGE(PG8_SA(1, 0), cA + kstep, voffA); PG8_STAGE(PG8_SB(1, 1), cB + hstepB + kstep, voffB);
        PG8_WAIT_V(6); PG8_BAR;
    }
    for (;;) {
        const bool has_next = S.next(ui + 1, nxt);
        const char* nA = has_next ? (const char*)g.A + (size_t)nxt.pm * tstepA : cA; const char* nB = has_next ? (const char*)g.Bt + (size_t)nxt.pn * tstepB : cB;
        for (int t = 0; t < nt; t += 2) {
            if constexpr (Epi::HAS_MID) { if (t == Epi::MID_T) E.mid(acc, cur, wr, fr); }
            const bool last = (t == nt - 2);
            const char* a1 = cA + (size_t)(t + 1) * kstep;
            const char* a2 = last ? nA : cA + (size_t)(t + 2) * kstep; const char* b2 = last ? nB : cB + (size_t)(t + 2) * kstep;
            const char* a3 = a2 + kstep; const char* b3 = b2 + kstep;
            if (last && has_next) S.a_ready(nxt);
            if constexpr (SP2) {
            PG8_LDB(B0, 0, 0); PG8_LDB(B1, 0, 1); PG8_SCHED; PG8_LDA(At, 0, 0); PG8_STAGE(PG8_SA(1, 1), a1 + hstepA, voffA);
            PG8_WAIT_V(8); PG8_WAIT_L(0); PG8_BAR; PG8_MMA(0, 0, At, B0); PG8_MMA(0, 1, At, B1); PG8_BAR; PG8_SCHED;
            PG8_LDA(At, 0, 1); PG8_STAGE(PG8_SB(0, 0), b2, voffB); PG8_STAGE(PG8_SB(0, 1), b2 + hstepB, voffB); PG8_STAGE(PG8_SA(0, 0), a2, voffA);
            PG8_WAIT_V(8); PG8_WAIT_L(0); PG8_BAR; PG8_MMA(1, 0, At, B0); PG8_MMA(1, 1, At, B1); PG8_BAR; PG8_SCHED;
            PG8_LDB(B0, 1, 0); PG8_LDB(B1, 1, 1); PG8_SCHED; PG8_LDA(At, 1, 0); PG8_STAGE(PG8_SA(0, 1), a2 + hstepA, voffA);
            PG8_WAIT_V(8); PG8_WAIT_L(0); PG8_BAR; PG8_MMA(0, 0, At, B0); PG8_MMA(0, 1, At, B1); PG8_BAR; PG8_SCHED;
            PG8_LDA(At, 1, 1); PG8_STAGE(PG8_SB(1, 0), b3, voffB); PG8_STAGE(PG8_SB(1, 1), b3 + hstepB, voffB); PG8_STAGE(PG8_SA(1, 0), a3, voffA);
            PG8_WAIT_V(8); PG8_WAIT_L(0); PG8_BAR; PG8_MMA(1, 0, At, B0); PG8_MMA(1, 1, At, B1); PG8_BAR; PG8_SCHED;
            } else {
            PG8_LDB(B0, 0, 0); PG8_SCHED; PG8_LDA(At, 0, 0); PG8_STAGE(PG8_SA(1, 1), a1 + hstepA, voffA);
            PG8_WAIT_L(8); PG8_BAR; PG8_WAIT_L(0); PG8_MMA(0, 0, At, B0); PG8_BAR; PG8_SCHED;
            PG8_LDB(B1, 0, 1); PG8_STAGE(PG8_SB(0, 0), b2, voffB);
            PG8_BAR; PG8_WAIT_L(0); PG8_MMA(0, 1, At, B1); PG8_BAR;
            PG8_LDA(At, 0, 1); PG8_STAGE(PG8_SA(0, 0), a2, voffA);
            PG8_BAR; PG8_WAIT_L(0); PG8_MMA(1, 0, At, B0); PG8_BAR; PG8_SCHED;
            PG8_STAGE(PG8_SB(0, 1), b2 + hstepB, voffB);
            PG8_WAIT_V(6); PG8_BAR; PG8_MMA(1, 1, At, B1); PG8_BAR;
            PG8_LDB(B0, 1, 0); PG8_SCHED; PG8_LDA(At, 1, 0); PG8_STAGE(PG8_SA(0, 1), a2 + hstepA, voffA);
            PG8_WAIT_L(8); PG8_BAR; PG8_WAIT_L(0); PG8_MMA(0, 0, At, B0); PG8_BAR; PG8_SCHED;
            PG8_LDB(B1, 1, 1); PG8_STAGE(PG8_SB(1, 0), b3, voffB);
            PG8_BAR; PG8_WAIT_L(0); PG8_MMA(0, 1, At, B1); PG8_BAR;
            PG8_LDA(At, 1, 1); PG8_STAGE(PG8_SA(1, 0), a3, voffA);
            PG8_BAR; PG8_WAIT_L(0); PG8_MMA(1, 0, At, B0); PG8_BAR; PG8_SCHED;
            PG8_STAGE(PG8_SB(1, 1), b3 + hstepB, voffB);
            PG8_WAIT_V(6); PG8_BAR; PG8_MMA(1, 1, At, B1); PG8_BAR;
            }
        }
        if constexpr (ALIGN_EPI) { if (wr == 0) PG8_BAR; }
        if constexpr (!Epi::AFTER_DRAIN) { E(acc, cur, wr, wc, fr, fq); S.done(cur); }
        if (!has_next) break;
#pragma unroll
        for (int a = 0; a < 2; ++a)
#pragma unroll
            for (int b = 0; b < 2; ++b)
#pragma unroll
                for (int m = 0; m < 4; ++m)
#pragma unroll
                    for (int n = 0; n < 2; ++n) acc[a][b][m][n] = (f32x4){0.f, 0.f, 0.f, 0.f};
        cur = nxt; cA = nA; cB = nB; ++ui;
        if constexpr (ALIGN_EPI) { if (wr == 1) PG8_BAR; }
    }
    PG8_WAIT_V(0);
    if constexpr (!ALIGN_EPI) { if (wr == 0) PG8_BAR; }
    PG8_BAR;
    if constexpr (Epi::AFTER_DRAIN) { E.fused(acc, cur, wr, wc, fr, fq, lds, wid, lane); S.done(cur); }
#undef PG8_SA
#undef PG8_SB
#undef PG8_STAGE
#undef PG8_LDA
#undef PG8_LDB
#undef PG8_MMA
#undef PG8_WAIT_V
#undef PG8_WAIT_L
#undef PG8_BAR
#undef PG8_SCHED
}
}

#define LAS __attribute__((address_space(3)))
typedef unsigned short bf16;
typedef float f32x4 __attribute__((ext_vector_type(4)));
typedef float f32x2 __attribute__((ext_vector_type(2)));
typedef short bf16x8 __attribute__((ext_vector_type(8)));
typedef short bf16x4 __attribute__((ext_vector_type(4)));
typedef unsigned u32x4 __attribute__((ext_vector_type(4)));
typedef unsigned u32x2 __attribute__((ext_vector_type(2)));
using pg8::Unit;

constexpr int NWAVES = 8, NTHR = 512;
constexpr int NT = 16384, DM = 1024, FF = 2816;
constexpr float EPS = 1e-6f;
constexpr int LDS_BYTES = 147456;
constexpr size_t MiB = 1u << 20, KiB = 1024;
constexpr size_t WS_SSQ1 = 0, WS_SSQ2 = 1 * MiB, WS_SSQ3 = 2 * MiB, WS_SSQG = 3 * MiB;
constexpr size_t WS_BAR = 5 * MiB, BAR_BYTES = 32 * KiB;
constexpr size_t WS_N1M = 4 * MiB, WS_GUM = 4 * MiB + 64 * KiB, WS_H1MF = 4 * MiB + 448 * KiB, WS_PM = 4 * MiB + 512 * KiB, WS_ST0 = 4 * MiB + 640 * KiB, WS_ZM = 4 * MiB + 896 * KiB, WS_A16 = 4 * MiB + 928 * KiB;
constexpr size_t WS_WGU1 = 8 * MiB, WS_WD1 = 19 * MiB, WS_Y = 8 * MiB;
constexpr size_t WS_WMAIN = 25 * MiB, WS_H1B = 29 * MiB, WS_WKV = 61 * MiB, WS_KVT = 29 * MiB;
constexpr size_t WS_WGLU = 63 * MiB, WS_WOUT = 64 * MiB, WS_WGU2 = 66 * MiB, WS_WD2 = 77 * MiB, WS_WY = 83 * MiB, WS_WZ = 89 * MiB, WS_ROT = 93 * MiB;
constexpr size_t WS_ACT = 98 * MiB, WS_Q = 98 * MiB, WS_K = 114 * MiB, WS_G = 130 * MiB, WS_KWT = 146 * MiB, WS_VT = 162 * MiB;
constexpr size_t WS_N1 = 186 * MiB, WS_UA = 186 * MiB, WS_MIX = 186 * MiB, WS_Z = 218 * MiB, WS_SPT = 234 * MiB, WS_END = 250 * MiB;

struct Args { const float* in[26]; float* out; unsigned char* ws; int ph_lo, ph_hi; };

__device__ __forceinline__ unsigned pk2(float lo, float hi) { unsigned r; asm volatile("v_cvt_pk_bf16_f32 %0, %1, %2" : "=v"(r) : "v"(lo), "v"(hi)); return r; }
__device__ __forceinline__ u32x4 pk8(f32x4 a, f32x4 b) { u32x4 w; w.x = pk2(a[0], a[1]); w.y = pk2(a[2], a[3]); w.z = pk2(b[0], b[1]); w.w = pk2(b[2], b[3]); return w; }
__device__ __forceinline__ float bf2f(unsigned short b) { return __uint_as_float((unsigned)b << 16); }
__device__ __forceinline__ float bflo(unsigned w) { return __uint_as_float(w << 16); }
__device__ __forceinline__ float bfhi(unsigned w) { return __uint_as_float(w & 0xffff0000u); }
__device__ __forceinline__ float sigmoidf_(float x) { return __builtin_amdgcn_rcpf(1.0f + __expf(-x)); }
__device__ __forceinline__ float siluf_(float x) { return x * sigmoidf_(x); }
__device__ __forceinline__ float gelu_tanh(float y) { return y * sigmoidf_(1.5957691216057308f * (y + 0.044715f * y * y * y)); }
__device__ __forceinline__ float wave_sum(float v) {
#pragma unroll
    for (int o = 1; o < 64; o <<= 1) v += __shfl_xor(v, o);
    return v;
}
__device__ __forceinline__ float sum4(f32x4 a) { return (a[0] + a[1]) + (a[2] + a[3]); }
__device__ __forceinline__ float sumsq4(f32x4 a) { return (a[0] * a[0] + a[1] * a[1]) + (a[2] * a[2] + a[3] * a[3]); }
__device__ __forceinline__ float rstd16(const float* ssq, int row) { return 1.0f / sqrtf(ssq[row] * (1.0f / 1024.0f) + EPS); }
__device__ __forceinline__ float ms8(const float* ssq, int row) { return ssq[row] * (1.0f / 512.0f) + EPS; }
__device__ __forceinline__ void ssq_add(float* p, float v) { (void)__hip_atomic_fetch_add(p, v, __ATOMIC_RELAXED, __HIP_MEMORY_SCOPE_AGENT); }
__device__ __forceinline__ float log2gamma(int h) { return log2f(1.0f - exp2f(-5.0f - (float)h)); }
__device__ __forceinline__ f32x4 mfma16(bf16x8 a, bf16x8 b, f32x4 c) { return __builtin_amdgcn_mfma_f32_16x16x32_bf16(a, b, c, 0, 0, 0); }

enum { MAP_PLAIN = 0, MAP_GU0 = 1, MAP_GU1 = 2, MAP_ROT = 3 };
struct TJob { const float* W; int ldw, col0, ncols, k0, kcnt; bf16* dst; int ldt, map, row_off; const float* ks; int ks_off; };
__device__ __forceinline__ int map_row(int map, int row_off, int n) {
    if (map == MAP_PLAIN) return row_off + n;
    if (map == MAP_GU0) return 256 * (n >> 7) + (n & 127);
    if (map == MAP_GU1) return 256 * (n >> 7) + 128 + (n & 127);
    const int h = n >> 7, d = n & 127; return row_off + 256 * (h >> 1) + 128 * (d >> 6) + 64 * (h & 1) + (d & 63);
}
constexpr int NJOBS = 15;
__device__ __forceinline__ TJob get_job(int j, const Args& a) {
    unsigned char* ws = a.ws; TJob t;
    t.W = nullptr; t.ldw = 0; t.col0 = 0; t.ncols = 0; t.k0 = 0; t.kcnt = 0; t.dst = nullptr; t.ldt = 0; t.map = MAP_PLAIN; t.row_off = 0; t.ks = nullptr; t.ks_off = 0;
    switch (j) {
    case 0: t.W = a.in[3]; t.ldw = FF; t.ncols = FF; t.kcnt = DM; t.dst = (bf16*)(ws + WS_WGU1); t.ldt = DM; t.map = MAP_GU0; break;
    case 1: t.W = a.in[4]; t.ldw = FF; t.ncols = FF; t.kcnt = DM; t.dst = (bf16*)(ws + WS_WGU1); t.ldt = DM; t.map = MAP_GU1; break;
    case 2: t.W = a.in[5]; t.ldw = DM; t.ncols = DM; t.kcnt = FF; t.dst = (bf16*)(ws + WS_WD1); t.ldt = FF; break;
    case 3: t.W = a.in[7]; t.ldw = 2560; t.col0 = 0; t.ncols = 512; t.kcnt = DM; t.dst = (bf16*)(ws + WS_WMAIN); t.ldt = DM; t.map = MAP_ROT; t.row_off = 0; t.ks = a.in[6]; break;
    case 4: t.W = a.in[7]; t.ldw = 2560; t.col0 = 512; t.ncols = 512; t.kcnt = DM; t.dst = (bf16*)(ws + WS_WMAIN); t.ldt = DM; t.map = MAP_ROT; t.row_off = 512; t.ks = a.in[6]; break;
    case 5: t.W = a.in[7]; t.ldw = 2560; t.col0 = 1536; t.ncols = 512; t.kcnt = DM; t.dst = (bf16*)(ws + WS_WMAIN); t.ldt = DM; t.row_off = 1024; t.ks = a.in[6]; break;
    case 6: t.W = a.in[7]; t.ldw = 2560; t.col0 = 2048; t.ncols = 512; t.kcnt = DM; t.dst = (bf16*)(ws + WS_WMAIN); t.ldt = DM; t.row_off = 1536; t.ks = a.in[6]; break;
    case 7: t.W = a.in[7]; t.ldw = 2560; t.col0 = 512; t.ncols = 512; t.kcnt = DM; t.dst = (bf16*)(ws + WS_WKV); t.ldt = DM; t.map = MAP_ROT; t.row_off = 0; t.ks = a.in[6]; break;
    case 8: t.W = a.in[7]; t.ldw = 2560; t.col0 = 1024; t.ncols = 512; t.kcnt = DM; t.dst = (bf16*)(ws + WS_WKV); t.ldt = DM; t.row_off = 512; t.ks = a.in[6]; break;
    case 9: t.W = a.in[17]; t.ldw = 512; t.ncols = 512; t.kcnt = 512; t.dst = (bf16*)(ws + WS_WGLU); t.ldt = 512; break;
    case 10: t.W = a.in[20]; t.ldw = DM; t.ncols = DM; t.k0 = 0; t.kcnt = 512; t.dst = (bf16*)(ws + WS_WOUT); t.ldt = DM; break;
    case 11: t.W = a.in[20]; t.ldw = DM; t.ncols = DM; t.k0 = 512; t.kcnt = 512; t.dst = (bf16*)(ws + WS_WOUT); t.ldt = DM; t.ks = a.in[19]; t.ks_off = 512; break;
    case 12: t.W = a.in[22]; t.ldw = FF; t.ncols = FF; t.kcnt = DM; t.dst = (bf16*)(ws + WS_WGU2); t.ldt = DM; t.map = MAP_GU0; t.ks = a.in[21]; break;
    case 13: t.W = a.in[23]; t.ldw = FF; t.ncols = FF; t.kcnt = DM; t.dst = (bf16*)(ws + WS_WGU2); t.ldt = DM; t.map = MAP_GU1; t.ks = a.in[21]; break;
    default: t.W = a.in[24]; t.ldw = DM; t.ncols = DM; t.kcnt = FF; t.dst = (bf16*)(ws + WS_WD2); t.ldt = FF; break;
    }
    return t;
}
__device__ __forceinline__ void tr_item(const TJob& J, int item, LAS float* scr, int lane) {
    const int nblk = J.ncols >> 5, kb = item / nblk, nb = item - kb * nblk, k0 = J.k0 + 64 * kb, n0 = 32 * nb;
#pragma unroll
    for (int i = 0; i < 32; ++i) { const int kk = 2 * i + (lane >> 5); float v = J.W[(size_t)(k0 + kk) * J.ldw + J.col0 + n0 + (lane & 31)]; if (J.ks) v *= J.ks[k0 + kk - J.ks_off]; scr[kk * 33 + (lane & 31)] = v; }
    asm volatile("s_waitcnt lgkmcnt(0)" ::: "memory");
    const int c = lane & 7;
#pragma unroll
    for (int j = 0; j < 4; ++j) { const int n = (lane >> 3) + 8 * j; const LAS float* s = scr + (8 * c) * 33 + n;
        u32x4 o; o.x = pk2(s[0 * 33], s[1 * 33]); o.y = pk2(s[2 * 33], s[3 * 33]); o.z = pk2(s[4 * 33], s[5 * 33]); o.w = pk2(s[6 * 33], s[7 * 33]);
        *(u32x4*)(J.dst + (size_t)map_row(J.map, J.row_off, n0 + n) * J.ldt + k0 + 8 * c) = o; }
    asm volatile("s_waitcnt lgkmcnt(0)" ::: "memory");
}
__device__ __forceinline__ void tr_load(const TJob& J, int item, f32x2 (&r)[32], int lane) {
    const int nblk = J.ncols >> 7, kb = item / nblk, nb = item - kb * nblk, k0 = J.k0 + 32 * kb, n0 = 128 * nb;
    const float* wp = J.W + (size_t)k0 * J.ldw + J.col0 + n0 + 2 * lane;
    if (J.ks) { const float* kp = J.ks + (k0 - J.ks_off);
#pragma unroll
        for (int kk = 0; kk < 32; ++kk) r[kk] = *(const f32x2*)(wp + (size_t)kk * J.ldw) * kp[kk];
    } else {
#pragma unroll
        for (int kk = 0; kk < 32; ++kk) r[kk] = *(const f32x2*)(wp + (size_t)kk * J.ldw);
    }
}
__device__ __forceinline__ void tr_put(const f32x2 (&r)[32], LAS float* scr, int lane) {
#pragma unroll
    for (int kk = 0; kk < 32; ++kk) { scr[kk * 129 + 2 * lane] = r[kk].x; scr[kk * 129 + 2 * lane + 1] = r[kk].y; }
    asm volatile("s_waitcnt lgkmcnt(0)" ::: "memory");
}
__device__ __forceinline__ void tr_flush(const TJob& J, int item, LAS float* scr, int lane) {
    const int nblk = J.ncols >> 7, kb = item / nblk, nb = item - kb * nblk, k0 = J.k0 + 32 * kb, n0 = 128 * nb, c = lane & 3;
#pragma unroll
    for (int j = 0; j < 8; ++j) { const int n = (lane >> 2) + 16 * j; const LAS float* s = scr + (8 * c) * 129 + n;
        u32x4 o; o.x = pk2(s[0 * 129], s[1 * 129]); o.y = pk2(s[2 * 129], s[3 * 129]); o.z = pk2(s[4 * 129], s[5 * 129]); o.w = pk2(s[6 * 129], s[7 * 129]);
        *(u32x4*)(J.dst + (size_t)map_row(J.map, J.row_off, n0 + n) * J.ldt + k0 + 8 * c) = o; }
    asm volatile("s_waitcnt lgkmcnt(0)" ::: "memory");
}
struct TrIter { int it, j, base, cnt, jend, limit, valid, pad_; TJob J; };
__device__ __forceinline__ void tr_seek(TrIter& I, const Args& a) {
    while (I.j < I.jend && I.it >= I.base + I.cnt) { I.base += I.cnt; ++I.j; if (I.j < I.jend) { I.J = get_job(I.j, a); I.cnt = (I.J.kcnt >> 5) * (I.J.ncols >> 7); } }
    I.valid = (I.j < I.jend && I.it < I.limit) ? 1 : 0;
}
__device__ __forceinline__ void tr_run(const Args& a, int j0, int jend, int it0, int stride, LAS float* scr, int lane, int limit = 0x7fffffff) {
    TrIter I; I.it = it0; I.j = j0; I.base = 0; I.jend = jend; I.limit = limit; I.valid = 0; I.pad_ = 0; I.J = get_job(j0, a); I.cnt = (I.J.kcnt >> 5) * (I.J.ncols >> 7); tr_seek(I, a);
    f32x2 r[32];
    if (I.valid) tr_load(I.J, I.it - I.base, r, lane);
    while (I.valid) {
        TrIter N = I; N.it += stride; tr_seek(N, a);
        tr_put(r, scr, lane);
        if (N.valid) tr_load(N.J, N.it - N.base, r, lane);
        tr_flush(I.J, I.it - I.base, scr, lane);
        I = N;
    }
}
__device__ __forceinline__ void rms_rows4_to_bf16(const float* x0, size_t xstride, const float* w, bf16* o0, size_t ostride, int lane) {
    f32x4 v[4][4]; const f32x4* wr = (const f32x4*)w + lane;
#pragma unroll
    for (int q = 0; q < 4; ++q)
#pragma unroll
        for (int j = 0; j < 4; ++j) v[q][j] = ((const f32x4*)(x0 + q * xstride) + lane)[64 * j];
    float rs[4];
#pragma unroll
    for (int q = 0; q < 4; ++q) { float ss = 0.f;
#pragma unroll
        for (int j = 0; j < 4; ++j) ss += sumsq4(v[q][j]);
        rs[q] = 1.0f / sqrtf(wave_sum(ss) * (1.0f / 1024.0f) + EPS); }
#pragma unroll
    for (int j = 0; j < 4; ++j) { const f32x4 g = wr[64 * j];
#pragma unroll
        for (int q = 0; q < 4; ++q) { u32x2 o; o.x = pk2(v[q][j][0] * rs[q] * g[0], v[q][j][1] * rs[q] * g[1]); o.y = pk2(v[q][j][2] * rs[q] * g[2], v[q][j][3] * rs[q] * g[3]); ((u32x2*)(o0 + q * ostride) + lane)[64 * j] = o; } }
}
__device__ __forceinline__ void rms_row_to_bf16(const float* xrow, const float* w, bf16* orow, int lane) {
    const f32x4* xr = (const f32x4*)xrow + lane; const f32x4* wr = (const f32x4*)w + lane;
    f32x4 v[4]; float s = 0.f;
#pragma unroll
    for (int j = 0; j < 4; ++j) { v[j] = xr[64 * j]; s += sumsq4(v[j]); }
    const float rstd = 1.0f / sqrtf(wave_sum(s) * (1.0f / 1024.0f) + EPS);
    u32x2* o8 = (u32x2*)orow + lane;
#pragma unroll
    for (int j = 0; j < 4; ++j) { const f32x4 g = wr[64 * j]; u32x2 o; o.x = pk2(v[j][0] * rstd * g[0], v[j][1] * rstd * g[1]); o.y = pk2(v[j][2] * rstd * g[2], v[j][3] * rstd * g[3]); o8[64 * j] = o; }
}
__device__ __forceinline__ void rms_rows2_to_bf16(const float* xa, const float* xb, const float* w, bf16* oa, bf16* ob, int lane) {
    const f32x4* pa = (const f32x4*)xa + lane; const f32x4* pb = (const f32x4*)xb + lane; const f32x4* wr = (const f32x4*)w + lane;
    f32x4 va[4], vb[4]; float sa = 0.f, sb = 0.f;
#pragma unroll
    for (int j = 0; j < 4; ++j) { va[j] = pa[64 * j]; vb[j] = pb[64 * j]; }
#pragma unroll
    for (int j = 0; j < 4; ++j) { sa += sumsq4(va[j]); sb += sumsq4(vb[j]); }
    const float ra = 1.0f / sqrtf(wave_sum(sa) * (1.0f / 1024.0f) + EPS), rb = 1.0f / sqrtf(wave_sum(sb) * (1.0f / 1024.0f) + EPS);
    u32x2* qa = (u32x2*)oa + lane; u32x2* qb = (u32x2*)ob + lane;
#pragma unroll
    for (int j = 0; j < 4; ++j) { const f32x4 g = wr[64 * j]; u32x2 o; o.x = pk2(va[j][0] * ra * g[0], va[j][1] * ra * g[1]); o.y = pk2(va[j][2] * ra * g[2], va[j][3] * ra * g[3]); qa[64 * j] = o;
        o.x = pk2(vb[j][0] * rb * g[0], vb[j][1] * rb * g[1]); o.y = pk2(vb[j][2] * rb * g[2], vb[j][3] * rb * g[3]); qb[64 * j] = o; }
}
__device__ __forceinline__ f32x2 cmul(f32x2 a, f32x2 b) { return (f32x2){a.x * b.x - a.y * b.y, a.x * b.y + a.y * b.x}; }

__device__ __forceinline__ void ssm_mats(const Args& a, int g, LAS unsigned char* lds, int tid) {
    LAS f32x2* apow = (LAS f32x2*)lds;
    LAS f32x2* bbar = apow + 17 * 64;
    LAS f32x2* Cc = bbar + 1024;
    LAS float* Km = (LAS float*)(Cc + 1024);
    LAS f32x2* cfs = (LAS f32x2*)(Km + 4096);
    unsigned char* ws = a.ws;
    for (int idx = tid; idx < 17 * 64; idx += NTHR) {
        const int j = idx >> 6, n = idx & 63; const float lre = a.in[9][g * 64 + n], lim = a.in[10][g * 64 + n], dt = expf(a.in[11][g]);
        const float mag = expf((float)j * lre * dt); float sn, cs; sincosf((float)j * (lim * dt), &sn, &cs); const f32x2 ap = (f32x2){mag * cs, mag * sn}; apow[idx] = ap;
        if (j == 16) ((f32x2*)(ws + WS_A16))[g * 64 + n] = ap;
        if (j == 1) { const float nx = ap.x - 1.0f, ny = ap.y, den = lre * lre + lim * lim; cfs[n] = (f32x2){(nx * lre + ny * lim) / den, (ny * lre - nx * lim) / den}; }
    }
    __syncthreads();
    for (int idx = tid; idx < 1024; idx += NTHR) {
        { const int n = idx >> 4, q = idx & 15; const f32x2 b = (f32x2){a.in[12][(size_t)(g * 64 + n) * 16 + q], a.in[13][(size_t)(g * 64 + n) * 16 + q]}; bbar[idx] = cmul(cfs[n], b); }
        { const int p = idx >> 6, n = idx & 63; Cc[idx] = (f32x2){a.in[14][(size_t)(g * 16 + p) * 64 + n], a.in[15][(size_t)(g * 16 + p) * 64 + n]}; }
    }
    __syncthreads();
    {
        const int j = tid >> 5, p = (tid >> 1) & 15, qh = tid & 1; float acc[8];
#pragma unroll
        for (int q = 0; q < 8; ++q) acc[q] = 0.f;
        for (int n = 0; n < 64; ++n) { const f32x2 ca = cmul(Cc[p * 64 + n], apow[j * 64 + n]);
#pragma unroll
            for (int q = 0; q < 8; ++q) { const f32x2 b = bbar[n * 16 + qh * 8 + q]; acc[q] += ca.x * b.x - ca.y * b.y; } }
#pragma unroll
        for (int q = 0; q < 8; ++q) Km[(j * 16 + p) * 16 + qh * 8 + q] = acc[q];
    }
    __syncthreads();
    bf16* WY = (bf16*)(ws + WS_WY) + (size_t)g * 256 * 384; bf16* WZ = (bf16*)(ws + WS_WZ) + (size_t)g * 256 * 256;
    for (int idx = tid; idx < 256 * 192; idx += NTHR) {
        const int r = idx / 192, c = 2 * (idx - r * 192), t = r >> 4, p = r & 15; float v0, v1;
        if (c < 256) { const int s = c >> 4, q = c & 15; if (t >= s) { v0 = Km[((t - s) * 16 + p) * 16 + q]; v1 = Km[((t - s) * 16 + p) * 16 + q + 1]; } else { v0 = 0.f; v1 = 0.f; } }
        else { const int nn = c - 256, n = nn & 63; const f32x2 c0 = cmul(Cc[p * 64 + n], apow[(t + 1) * 64 + n]), c1 = cmul(Cc[p * 64 + n + 1], apow[(t + 1) * 64 + n + 1]);
            if (nn < 64) { v0 = c0.x; v1 = c1.x; } else { v0 = -c0.y; v1 = -c1.y; } }
        *(unsigned*)(WY + (size_t)r * 384 + c) = pk2(v0, v1);
    }
    for (int idx = tid; idx < 256 * 128; idx += NTHR) {
        const int r = idx >> 7, c = 2 * (idx & 127), s = c >> 4, q = c & 15; float v0 = 0.f, v1 = 0.f;
        if (r < 128) { const int n = r & 63; const f32x2 z0 = cmul(apow[(15 - s) * 64 + n], bbar[n * 16 + q]), z1 = cmul(apow[(15 - s) * 64 + n], bbar[n * 16 + q + 1]);
            if (r < 64) { v0 = z0.x; v1 = z1.x; } else { v0 = z0.y; v1 = z1.y; } }
        *(unsigned*)(WZ + (size_t)r * 256 + c) = pk2(v0, v1);
    }
    __syncthreads();
}

template <class AL, class EP>
__device__ __forceinline__ void skinny(const bf16* Bt, int ldb, int ngroups, int nsplit, int K, int task0, int ntask_stride, const AL& al, const EP& ep, int lane) {
    const int fr = lane & 15, fq = lane >> 4, kper = K / nsplit;
    for (int t = task0; t < ngroups * nsplit; t += ntask_stride) {
        const int grp = t % ngroups, sp = t / ngroups;
        f32x4 acc = (f32x4){0.f, 0.f, 0.f, 0.f};
        const bf16* bp = Bt + (size_t)(grp * 16 + fr) * ldb + fq * 8;
#pragma unroll 4
        for (int k = sp * kper; k < (sp + 1) * kper; k += 32) { const bf16x8 b = *(const bf16x8*)(bp + k); const bf16x8 av = al(fr, k + fq * 8); acc = mfma16(b, av, acc); }
        ep(fr, grp * 16 + fq * 4, acc);
    }
}
struct ALBf16 { const bf16* A; int lda; __device__ __forceinline__ bf16x8 operator()(int r, int k) const { return *(const bf16x8*)(A + (size_t)r * lda + k); } };
struct ALF32 { const float* A; int lda; __device__ __forceinline__ bf16x8 operator()(int r, int k) const { const f32x4* p = (const f32x4*)(A + (size_t)r * lda + k); return __builtin_bit_cast(bf16x8, pk8(p[0], p[1])); } };
struct ALSwiGLU { const float* GU; __device__ __forceinline__ bf16x8 operator()(int r, int k) const {
        const float* p = GU + (size_t)r * 5632 + 256 * (k >> 7) + (k & 127); const f32x4 g0 = *(const f32x4*)p, g1 = *(const f32x4*)(p + 4), u0 = *(const f32x4*)(p + 128), u1 = *(const f32x4*)(p + 132); f32x4 a0, a1;
#pragma unroll
        for (int e = 0; e < 4; ++e) { a0[e] = siluf_(g0[e]) * u0[e]; a1[e] = siluf_(g1[e]) * u1[e]; }
        return __builtin_bit_cast(bf16x8, pk8(a0, a1)); } };
struct EPStore { float* O; int ldo; __device__ __forceinline__ void operator()(int r, int c, f32x4 v) const { *(f32x4*)(O + (size_t)r * ldo + c) = v; } };
struct EPAtomic { float* O; int ldo; float sc; __device__ __forceinline__ void operator()(int r, int c, f32x4 v) const { float* p = O + (size_t)r * ldo + c;
#pragma unroll
        for (int e = 0; e < 4; ++e) ssq_add(p + e, sc * v[e]); } };

struct P3Order {
    int G, c;
    __device__ bool next(int i, Unit& u) const {
        if (G == 256) { if (i > 2) return false; const int c4 = c >> 2, sub = c & 3;
            if (i < 2) { u.pm = c4; u.pn = (sub < 2) ? (4 + 2 * i + sub) : (2 * i + sub - 2); } else { u.pn = 8 + c4; u.pm = 64 + sub; } return true; }
        const int L = i * G + c; if (L >= 768) return false;
        if (L < 512) { u.pm = L >> 3; u.pn = L & 7; } else { const int l = L - 512; u.pn = 8 + (l >> 2); u.pm = 64 + (l & 3); } return true; }
    __device__ __forceinline__ void a_ready(const Unit&) const {}
    __device__ __forceinline__ void done(const Unit&) const {}
};
struct GroupOrder {
    int G, c;
    __device__ bool next(int i, Unit& u) const { const int L = i * G + c; if (L >= 128) return false; u.pm = L; u.pn = L >> 2; return true; }
    __device__ __forceinline__ void a_ready(const Unit&) const {}
    __device__ __forceinline__ void done(const Unit&) const {}
};

struct EpiSwiGLU {
    static constexpr bool PERM = true, AFTER_DRAIN = false, HAS_MID = false;
    bf16* O; const float* ssq;
    __device__ __forceinline__ void operator()(const f32x4 (&acc)[2][2][4][2], const Unit& u, int wr, int wc, int fr, int fq) const {
        asm volatile("" : "+v"(fr), "+v"(fq));
        const int col0 = u.pn * 128 + wc * 32 + 8 * fq;
#pragma unroll
        for (int ai = 0; ai < 2; ++ai)
#pragma unroll
            for (int m = 0; m < 4; ++m) { const int row = u.pm * 256 + ai * 128 + wr * 64 + m * 16 + fr; const float rs = ssq ? rstd16(ssq, row) : 1.0f;
                f32x4 a0, a1;
#pragma unroll
                for (int e = 0; e < 4; ++e) { a0[e] = siluf_(acc[ai][0][m][0][e] * rs) * (acc[ai][1][m][0][e] * rs); a1[e] = siluf_(acc[ai][0][m][1][e] * rs) * (acc[ai][1][m][1][e] * rs); }
                *(u32x4*)(O + (size_t)row * FF + col0) = pk8(a0, a1); asm volatile("" ::: "memory"); }
    }
};
template <int MODE>
struct EpiRes {
    static constexpr bool PERM = true, AFTER_DRAIN = false, HAS_MID = (MODE == 1); static constexpr int MID_T = 8;
    const float* base; float* out; bf16* hb; float* ssq_out; const float* ssqg;
    __device__ __forceinline__ void mid(f32x4 (&acc)[2][2][4][2], const Unit& u, int wr, int fr) const {
#pragma unroll
        for (int ai = 0; ai < 2; ++ai)
#pragma unroll
            for (int m = 0; m < 4; ++m) { const int row = u.pm * 256 + ai * 128 + wr * 64 + m * 16 + fr; const float f = sqrtf(ms8(ssqg, row));
#pragma unroll
                for (int bj = 0; bj < 2; ++bj)
#pragma unroll
                    for (int n = 0; n < 2; ++n) acc[ai][bj][m][n] = acc[ai][bj][m][n] * f; }
    }
    __device__ __forceinline__ void operator()(const f32x4 (&acc)[2][2][4][2], const Unit& u, int wr, int wc, int fr, int fq) const {
        asm volatile("" : "+v"(fr), "+v"(fq));
#pragma unroll
        for (int ai = 0; ai < 2; ++ai)
#pragma unroll
            for (int m = 0; m < 4; ++m) { const int row = u.pm * 256 + ai * 128 + wr * 64 + m * 16 + fr; const float sc = MODE == 0 ? 0.5f : 1.0f / sqrtf(ms8(ssqg, row)); float ss = 0.f;
#pragma unroll
                for (int bj = 0; bj < 2; ++bj) { const size_t off = (size_t)row * DM + u.pn * 256 + bj * 128 + wc * 32 + 8 * fq;
                    const f32x4 b0 = *(const f32x4*)(base + off), b1 = *(const f32x4*)(base + off + 4); const f32x4 h0 = b0 + sc * acc[ai][bj][m][0], h1 = b1 + sc * acc[ai][bj][m][1];
                    *(f32x4*)(out + off) = h0; *(f32x4*)(out + off + 4) = h1; if (hb) *(u32x4*)(hb + off) = pk8(h0, h1); ss += sumsq4(h0) + sumsq4(h1); }
                ss += __shfl_xor(ss, 16); ss += __shfl_xor(ss, 32);
                if (fq == 0) ssq_add(ssq_out + row, ss); asm volatile("" ::: "memory"); }
    }
};
struct EpiFinal {
    static constexpr bool PERM = true, AFTER_DRAIN = false, HAS_MID = false;
    const float* base; float* out; float* ssq; unsigned* cnt; const float* w;
    __device__ __forceinline__ void operator()(f32x4 (&acc)[2][2][4][2], const Unit& u, int wr, int wc, int fr, int fq) const {
        asm volatile("" : "+v"(fr), "+v"(fq));
#pragma unroll
        for (int ai = 0; ai < 2; ++ai)
#pragma unroll
            for (int m = 0; m < 4; ++m) { const int row = u.pm * 256 + ai * 128 + wr * 64 + m * 16 + fr; float ss = 0.f;
#pragma unroll
                for (int bj = 0; bj < 2; ++bj) { const size_t off = (size_t)row * DM + u.pn * 256 + bj * 128 + wc * 32 + 8 * fq;
                    const f32x4 b0 = *(const f32x4*)(base + off), b1 = *(const f32x4*)(base + off + 4); const f32x4 h0 = b0 + 0.5f * acc[ai][bj][m][0], h1 = b1 + 0.5f * acc[ai][bj][m][1];
                    acc[ai][bj][m][0] = h0; acc[ai][bj][m][1] = h1; ss += sumsq4(h0) + sumsq4(h1); }
                ss += __shfl_xor(ss, 16); ss += __shfl_xor(ss, 32);
                if (fq == 0) ssq_add(ssq + row, ss); asm volatile("" ::: "memory"); }
        asm volatile("s_waitcnt vmcnt(0)" ::: "memory");
        unsigned* c = cnt + 64 * u.pm;
        if (fr == 0 && fq == 0) (void)__hip_atomic_fetch_add(c, 1u, __ATOMIC_RELAXED, __HIP_MEMORY_SCOPE_AGENT);
        for (unsigned sp = 0; sp < (1u << 20); ++sp) { if ((unsigned)__builtin_amdgcn_readfirstlane(__hip_atomic_load(c, __ATOMIC_RELAXED, __HIP_MEMORY_SCOPE_AGENT)) >= 32u) break; __builtin_amdgcn_s_sleep(2); }
        asm volatile("" ::: "memory");
#pragma unroll
        for (int ai = 0; ai < 2; ++ai)
#pragma unroll
            for (int m = 0; m < 4; ++m) { const int row = u.pm * 256 + ai * 128 + wr * 64 + m * 16 + fr;
                const float rs = 1.0f / sqrtf(__hip_atomic_load(ssq + row, __ATOMIC_RELAXED, __HIP_MEMORY_SCOPE_AGENT) * (1.0f / 1024.0f) + EPS);
#pragma unroll
                for (int bj = 0; bj < 2; ++bj) { const int col = u.pn * 256 + bj * 128 + wc * 32 + 8 * fq; const size_t off = (size_t)row * DM + col;
                    const f32x4 w0 = *(const f32x4*)(w + col), w1 = *(const f32x4*)(w + col + 4);
                    *(f32x4*)(out + off) = acc[ai][bj][m][0] * rs * w0; *(f32x4*)(out + off + 4) = acc[ai][bj][m][1] * rs * w1; }
                asm volatile("" ::: "memory"); }
    }
};
struct EpiInProj {
    static constexpr bool PERM = true, AFTER_DRAIN = false, HAS_MID = false;
    const float* ssq1; const f32x2* rot; bf16 *Q, *K, *G, *UA, *KWT, *VT;
    __device__ __forceinline__ void operator()(const f32x4 (&acc)[2][2][4][2], const Unit& u, int wr, int wc, int fr, int fq) const {
        asm volatile("" : "+v"(fr), "+v"(fq));
        if (u.pm < 64) {
#ifndef NO_NORMAL
            const int pn = u.pn;
            if (pn < 4) {
                bf16* O = pn < 2 ? Q : K; const float sc = pn < 2 ? 1.0f : 0.08838834764831845f; const int p0 = wc * 32 + 8 * fq, head = 2 * (pn & 1) + (p0 >> 6), i0 = p0 & 63;
#pragma unroll
                for (int ai = 0; ai < 2; ++ai)
#pragma unroll
                    for (int m = 0; m < 4; ++m) { const int row = u.pm * 256 + ai * 128 + wr * 64 + m * 16 + fr; const float rs = rstd16(ssq1, row) * sc; const int pos = 16 + (row & 8191);
                        const f32x4* rp = (const f32x4*)(rot + (size_t)pos * 64 + i0); f32x4 o1[2], o2[2];
#pragma unroll
                        for (int n = 0; n < 2; ++n) { const f32x4 ra = rp[2 * n], rb = rp[2 * n + 1]; const f32x4 x1 = acc[ai][0][m][n], x2 = acc[ai][1][m][n];
                            o1[n][0] = (x1[0] * ra[0] - x2[0] * ra[1]) * rs; o2[n][0] = (x1[0] * ra[1] + x2[0] * ra[0]) * rs;
                            o1[n][1] = (x1[1] * ra[2] - x2[1] * ra[3]) * rs; o2[n][1] = (x1[1] * ra[3] + x2[1] * ra[2]) * rs;
                            o1[n][2] = (x1[2] * rb[0] - x2[2] * rb[1]) * rs; o2[n][2] = (x1[2] * rb[1] + x2[2] * rb[0]) * rs;
                            o1[n][3] = (x1[3] * rb[2] - x2[3] * rb[3]) * rs; o2[n][3] = (x1[3] * rb[3] + x2[3] * rb[2]) * rs; }
                        bf16* op = O + (size_t)row * 512 + head * 128 + i0; *(u32x4*)op = pk8(o1[0], o1[1]); *(u32x4*)(op + 64) = pk8(o2[0], o2[1]); asm volatile("" ::: "memory"); if (m & 1) __builtin_amdgcn_sched_barrier(0); }
            } else if (pn < 6) {
#pragma unroll
                for (int ai = 0; ai < 2; ++ai)
#pragma unroll
                    for (int m = 0; m < 4; ++m) { const int row = u.pm * 256 + ai * 128 + wr * 64 + m * 16 + fr; const float rs = rstd16(ssq1, row);
#pragma unroll
                        for (int bj = 0; bj < 2; ++bj) *(u32x4*)(G + (size_t)row * 512 + (pn - 4) * 256 + bj * 128 + wc * 32 + 8 * fq) = pk8(acc[ai][bj][m][0] * rs, acc[ai][bj][m][1] * rs); }
            } else {
#pragma unroll
                for (int ai = 0; ai < 2; ++ai)
#pragma unroll
                    for (int m = 0; m < 4; ++m) { const int row = u.pm * 256 + ai * 128 + wr * 64 + m * 16 + fr; const float rs = rstd16(ssq1, row); const int chunk = row >> 4, s = row & 15;
#pragma unroll
                        for (int bj = 0; bj < 2; ++bj) { const int ch = (pn - 6) * 256 + bj * 128 + wc * 32 + 8 * fq;
                            *(u32x4*)(UA + ((size_t)(ch >> 4) * 1024 + chunk) * 384 + s * 16 + (ch & 15)) = pk8(acc[ai][bj][m][0] * rs, acc[ai][bj][m][1] * rs); } }
            }
#endif
        } else {
#ifndef NO_SWAP
            const int tokb = (u.pn - 8) * 256 + wc * 32 + 8 * fq;
            if (u.pm < 66) {
                const int head = 2 * (u.pm - 64) + wr; const float l2g = log2gamma(head);
#pragma unroll
                for (int bj = 0; bj < 2; ++bj) { const int tok0 = tokb + bj * 128; float rs[8];
#pragma unroll
                    for (int e = 0; e < 8; ++e) rs[e] = rstd16(ssq1, tok0 + e) * 0.08838834764831845f * exp2f(l2g * (float)(127 - ((tok0 + e) & 127)));
#pragma unroll
                    for (int m = 0; m < 4; ++m) { const int i = 16 * m + fr; f32x4 o1[2], o2[2];
#pragma unroll
                        for (int e = 0; e < 8; ++e) { const int pos = 16 + ((tok0 + e) & 8191); const f32x2 cs = rot[(size_t)pos * 64 + i]; const float x1 = acc[0][bj][m][e >> 2][e & 3], x2 = acc[1][bj][m][e >> 2][e & 3];
                            o1[e >> 2][e & 3] = (x1 * cs.x - x2 * cs.y) * rs[e]; o2[e >> 2][e & 3] = (x1 * cs.y + x2 * cs.x) * rs[e]; }
                        *(u32x4*)(KWT + (size_t)(head * 128 + i) * NT + tok0) = pk8(o1[0], o1[1]); *(u32x4*)(KWT + (size_t)(head * 128 + 64 + i) * NT + tok0) = pk8(o2[0], o2[1]); asm volatile("" ::: "memory"); __builtin_amdgcn_sched_barrier(0); } }
            } else {
#pragma unroll
                for (int bj = 0; bj < 2; ++bj) { const int tok0 = tokb + bj * 128; f32x4 r0, r1;
#pragma unroll
                    for (int e = 0; e < 4; ++e) { r0[e] = rstd16(ssq1, tok0 + e); r1[e] = rstd16(ssq1, tok0 + 4 + e); }
#pragma unroll
                    for (int ai = 0; ai < 2; ++ai)
#pragma unroll
                        for (int m = 0; m < 4; ++m) { const int r = (u.pm - 66) * 256 + ai * 128 + wr * 64 + m * 16 + fr; *(u32x4*)(VT + (size_t)r * NT + tok0) = pk8(acc[ai][bj][m][0] * r0, acc[ai][bj][m][1] * r1); } }
            }
#endif
        }
    }
};
struct EpiZ {
    static constexpr bool PERM = true, AFTER_DRAIN = false, HAS_MID = false;
    float* Z;
    __device__ __forceinline__ void operator()(const f32x4 (&acc)[2][2][4][2], const Unit& u, int wr, int wc, int fr, int fq) const {
        asm volatile("" : "+v"(fr), "+v"(fq));
#pragma unroll
        for (int ai = 0; ai < 2; ++ai)
#pragma unroll
            for (int m = 0; m < 4; ++m) { const int row = u.pm * 256 + ai * 128 + wr * 64 + m * 16 + fr; float* p = Z + (size_t)row * 128 + wc * 32 + 8 * fq; *(f32x4*)p = acc[ai][0][m][0]; *(f32x4*)(p + 4) = acc[ai][0][m][1]; }
    }
};
struct EpiY {
    static constexpr bool PERM = true, AFTER_DRAIN = false, HAS_MID = false;
    const bf16* UA; const float* D; bf16* Y;
    __device__ __forceinline__ void operator()(const f32x4 (&acc)[2][2][4][2], const Unit& u, int wr, int wc, int fr, int fq) const {
        asm volatile("" : "+v"(fr), "+v"(fq));
        const int grp = u.pn, p0 = 8 * (fq & 1);
        const bf16* ub = UA + (size_t)(u.pm * 256 + wr * 64 + fr) * 384 + wc * 32 + 8 * fq;
        bf16* yb = Y + (size_t)((((u.pm & 3) * 256 + wr * 64 + fr) * 16) + wc * 2 + (fq >> 1)) * 512 + grp * 16 + p0;
        const f32x4 d0 = *(const f32x4*)(D + grp * 16 + p0), d1 = *(const f32x4*)(D + grp * 16 + p0 + 4);
#pragma unroll
        for (int ai = 0; ai < 2; ++ai)
#pragma unroll
            for (int m = 0; m < 4; ++m) {
#pragma unroll
                for (int bj = 0; bj < 2; ++bj) {
                    const u32x4 uv = *(const u32x4*)(ub + (ai * 128 + m * 16) * 384 + bj * 128);
                    f32x4 y0 = acc[ai][bj][m][0], y1 = acc[ai][bj][m][1];
                    y0[0] += d0[0] * bflo(uv.x); y0[1] += d0[1] * bfhi(uv.x); y0[2] += d0[2] * bflo(uv.y); y0[3] += d0[3] * bfhi(uv.y);
                    y1[0] += d1[0] * bflo(uv.z); y1[1] += d1[1] * bfhi(uv.z); y1[2] += d1[2] * bflo(uv.w); y1[3] += d1[3] * bfhi(uv.w);
#pragma unroll
                    for (int e = 0; e < 4; ++e) { y0[e] = gelu_tanh(y0[e]); y1[e] = gelu_tanh(y1[e]); }
                    *(u32x4*)(yb + (size_t)((ai * 128 + m * 16) * 16 + bj * 8) * 512) = pk8(y0, y1); __builtin_amdgcn_sched_barrier(0); }
                asm volatile("" ::: "memory"); }
    }
};
struct EpiGLU {
    static constexpr bool PERM = true, AFTER_DRAIN = false, HAS_MID = false;
    const bf16* Y; const float* bias; bf16* MIX; float* ssqg;
    __device__ __forceinline__ void operator()(const f32x4 (&acc)[2][2][4][2], const Unit& u, int wr, int wc, int fr, int fq) const {
        asm volatile("" : "+v"(fr), "+v"(fq));
#pragma unroll
        for (int ai = 0; ai < 2; ++ai)
#pragma unroll
            for (int m = 0; m < 4; ++m) { const int row = u.pm * 256 + ai * 128 + wr * 64 + m * 16 + fr; float ss = 0.f;
#pragma unroll
                for (int bj = 0; bj < 2; ++bj) { const int col = u.pn * 256 + bj * 128 + wc * 32 + 8 * fq;
                    const u32x4 yv = *(const u32x4*)(Y + (size_t)row * 512 + col); const f32x4 b0 = *(const f32x4*)(bias + col), b1 = *(const f32x4*)(bias + col + 4);
                    const f32x4 z0 = acc[ai][bj][m][0] + b0, z1 = acc[ai][bj][m][1] + b1; f32x4 y0, y1;
                    y0[0] = bflo(yv.x) * sigmoidf_(z0[0]); y0[1] = bfhi(yv.x) * sigmoidf_(z0[1]); y0[2] = bflo(yv.y) * sigmoidf_(z0[2]); y0[3] = bfhi(yv.y) * sigmoidf_(z0[3]);
                    y1[0] = bflo(yv.z) * sigmoidf_(z1[0]); y1[1] = bfhi(yv.z) * sigmoidf_(z1[1]); y1[2] = bflo(yv.w) * sigmoidf_(z1[2]); y1[3] = bfhi(yv.w) * sigmoidf_(z1[3]);
                    ss += sumsq4(y0) + sumsq4(y1); *(u32x4*)(MIX + (size_t)row * DM + 512 + col) = pk8(y0, y1); }
                ss += __shfl_xor(ss, 16); ss += __shfl_xor(ss, 32);
                if (fq == 0) ssq_add(ssqg + row, ss); asm volatile("" ::: "memory"); }
    }
};

#define LD16(off) (*(const bf16x8*)(ws + (off)))
#define LD8(off) (*(const u32x2*)(ws + (off)))
__device__ __forceinline__ void r1_item(int item, unsigned char* ws, int w, int lane) {
    const int bh = item >> 6, n = item & 63, b = bh >> 2, h = bh & 3, fr = lane & 15, fq = lane >> 4; const int tok0 = b * 8192 + n * 128;
    const unsigned voff = (unsigned)WS_VT + (unsigned)(((h * 128 + 16 * w + fr) * NT + tok0 + 8 * fq) * 2);
    const unsigned koff = (unsigned)WS_KWT + (unsigned)(((h * 128 + fr) * NT + tok0 + 8 * fq) * 2);
    bf16x8 vf[4];
#pragma unroll
    for (int ks = 0; ks < 4; ++ks) vf[ks] = LD16(voff + 64 * ks);
    const unsigned ooff = (unsigned)WS_KVT + (unsigned)((((bh * 64 + n) * 128 + 16 * w + 4 * fq) * 128 + fr) * 4);
#pragma unroll
    for (int dt = 0; dt < 8; ++dt) { f32x4 acc = (f32x4){0.f, 0.f, 0.f, 0.f};
#pragma unroll
        for (int ks = 0; ks < 4; ++ks) acc = mfma16(vf[ks], LD16(koff + (unsigned)(dt * 16 * NT * 2 + 64 * ks)), acc);
#pragma unroll
        for (int jj = 0; jj < 4; ++jj) *(float*)(ws + ooff + (unsigned)((jj * 128 + 16 * dt) * 4)) = acc[jj]; }
}
__device__ __forceinline__ void r3_item(int item, unsigned char* ws, const float* retw, int w, int lane) {
    const int bh = item >> 6, n = item & 63, b = bh >> 2, h = bh & 3, fr = lane & 15, fq = lane >> 4; const int tok0 = b * 8192 + n * 128, irow = tok0 + 16 * w + fr;
    const float l2g = log2gamma(h);
    const unsigned qoff = (unsigned)WS_Q + (unsigned)((irow * 512 + h * 128 + 8 * fq) * 2);
    const unsigned koff = (unsigned)WS_K + (unsigned)(((tok0 + fr) * 512 + h * 128 + 8 * fq) * 2);
    const unsigned voff = (unsigned)WS_VT + (unsigned)(((h * 128 + fr) * NT + tok0 + 4 * fq) * 2);
    const unsigned soff = (unsigned)WS_SPT + (unsigned)((((bh * 64 + n) * 128 + fr) * 128 + 8 * fq) * 2);
    const unsigned goff = (unsigned)WS_G + (unsigned)((irow * 512 + h * 128 + 4 * fq) * 2);
    const unsigned moff = (unsigned)WS_MIX + (unsigned)((irow * 1024 + h * 128 + 4 * fq) * 2);
    bf16x8 qf[4];
#pragma unroll
    for (int ks = 0; ks < 4; ++ks) qf[ks] = LD16(qoff + 64 * ks);
    f32x4 s[8];
#pragma unroll
    for (int jt = 0; jt < 8; ++jt) { s[jt] = (f32x4){0.f, 0.f, 0.f, 0.f};
        if (jt <= w) {
#pragma unroll
            for (int ks = 0; ks < 4; ++ks) s[jt] = mfma16(LD16(koff + (unsigned)(jt * 16 * 512 * 2 + 64 * ks)), qf[ks], s[jt]);
#pragma unroll
            for (int jj = 0; jj < 4; ++jj) { const int dd = 16 * (w - jt) + fr - 4 * fq - jj; s[jt][jj] = dd >= 0 ? s[jt][jj] * exp2f(l2g * (float)dd) : 0.f; } } }
    f32x4 o[8];
#pragma unroll
    for (int et = 0; et < 8; ++et) o[et] = (f32x4){0.f, 0.f, 0.f, 0.f};
#pragma unroll
    for (int kp = 0; kp < 4; ++kp) if (2 * kp <= w) { const bf16x8 sf = __builtin_bit_cast(bf16x8, pk8(s[2 * kp], s[2 * kp + 1]));
#pragma unroll
        for (int et = 0; et < 8; ++et) { const u32x2 v0 = LD8(voff + (unsigned)(et * 16 * NT * 2 + 64 * kp)), v1 = LD8(voff + (unsigned)(et * 16 * NT * 2 + 64 * kp + 32));
            const u32x4 vv = (u32x4){v0.x, v0.y, v1.x, v1.y}; o[et] = mfma16(__builtin_bit_cast(bf16x8, vv), sf, o[et]); } }
    const float wq = exp2f(l2g * (float)(16 * w + fr + 1)); float s1 = 0.f;
#pragma unroll
    for (int et = 0; et < 8; ++et) { f32x4 oc = (f32x4){0.f, 0.f, 0.f, 0.f};
#pragma unroll
        for (int ks = 0; ks < 4; ++ks) oc = mfma16(LD16(soff + (unsigned)(et * 16 * 128 * 2 + 64 * ks)), qf[ks], oc);
        o[et] = o[et] + wq * oc; s1 += sum4(o[et]); }
    s1 += __shfl_xor(s1, 16); s1 += __shfl_xor(s1, 32); const float mean = s1 * (1.0f / 128.0f); float s2 = 0.f;
#pragma unroll
    for (int et = 0; et < 8; ++et) { o[et] = o[et] - mean; s2 += sumsq4(o[et]); }
    s2 += __shfl_xor(s2, 16); s2 += __shfl_xor(s2, 32);
    const float msg = *(const float*)(ws + (unsigned)WS_SSQG + (unsigned)(irow * 4)) * (1.0f / 512.0f) + EPS;
    const float sc = (1.0f / sqrtf(s2 * (1.0f / 128.0f) + EPS)) * sqrtf(msg);
    const float* wnp = retw + h * 128 + 4 * fq;
#pragma unroll
    for (int et = 0; et < 8; ++et) { const f32x4 wn = *(const f32x4*)(wnp + 16 * et); const u32x2 gv = LD8(goff + 32 * et);
        u32x2 ov; ov.x = pk2(o[et][0] * sc * wn[0] * siluf_(bflo(gv.x)), o[et][1] * sc * wn[1] * siluf_(bfhi(gv.x))); ov.y = pk2(o[et][2] * sc * wn[2] * siluf_(bflo(gv.y)), o[et][3] * sc * wn[3] * siluf_(bfhi(gv.y)));
        *(u32x2*)(ws + moff + 32 * et) = ov; }
}
constexpr int RT_PITCH = 272, RT_TILE = 128 * RT_PITCH;
__device__ __forceinline__ void rt_load(u32x4 (&r)[4], const unsigned char* ws, unsigned goff, unsigned gpitch, int tid) {
#pragma unroll
    for (int i = 0; i < 4; ++i) { const int c = tid + 512 * i; r[i] = *(const u32x4*)(ws + goff + (unsigned)(c >> 4) * gpitch + (unsigned)(c & 15) * 16u); }
}
__device__ __forceinline__ void rt_store(const u32x4 (&r)[4], LAS unsigned char* t, int tid) {
#pragma unroll
    for (int i = 0; i < 4; ++i) { const int c = tid + 512 * i; *(LAS u32x4*)(t + (c >> 4) * RT_PITCH + (c & 15) * 16) = r[i]; }
}
#define LF16(t, row, col) (*(const LAS bf16x8*)((t) + (row) * RT_PITCH + (col) * 2))
#define LF8(t, row, col) (*(const LAS u32x2*)((t) + (row) * RT_PITCH + (col) * 2))
struct R1Regs { u32x4 rv[4], rk[4]; };
__device__ __forceinline__ void r1_loads(int item, const unsigned char* ws, R1Regs& R, int tid) {
    const int bh = item >> 6, n = item & 63, b = bh >> 2, h = bh & 3; const int tok0 = b * 8192 + n * 128;
    rt_load(R.rv, ws, (unsigned)WS_VT + (unsigned)((h * 128 * NT + tok0) * 2), NT * 2, tid); rt_load(R.rk, ws, (unsigned)WS_KWT + (unsigned)((h * 128 * NT + tok0) * 2), NT * 2, tid);
}
__device__ __forceinline__ void r1_item_pipe(int item, int nxt, R1Regs& R, unsigned char* ws, LAS unsigned char* lds, int w, int lane, int tid) {
    const int bh = item >> 6, n = item & 63, fr = lane & 15, fq = lane >> 4;
    LAS unsigned char* Vs = lds; LAS unsigned char* Ks = lds + RT_TILE;
    rt_store(R.rv, Vs, tid); rt_store(R.rk, Ks, tid);
    if (nxt >= 0) r1_loads(nxt, ws, R, tid);
    __syncthreads();
    bf16x8 vf[4];
#pragma unroll
    for (int ks = 0; ks < 4; ++ks) vf[ks] = LF16(Vs, 16 * w + fr, 32 * ks + 8 * fq);
    const unsigned ooff = (unsigned)WS_KVT + (unsigned)((((bh * 64 + n) * 128 + 16 * w + 4 * fq) * 128 + fr) * 4);
#pragma unroll
    for (int dt = 0; dt < 8; ++dt) { f32x4 acc = (f32x4){0.f, 0.f, 0.f, 0.f};
#pragma unroll
        for (int ks = 0; ks < 4; ++ks) acc = mfma16(vf[ks], LF16(Ks, 16 * dt + fr, 32 * ks + 8 * fq), acc);
#pragma unroll
        for (int jj = 0; jj < 4; ++jj) *(float*)(ws + ooff + (unsigned)((jj * 128 + 16 * dt) * 4)) = acc[jj]; }
    __syncthreads();
}
struct R3Regs { u32x4 rq[4], rk[4], rv[4], rs[4]; };
__device__ __forceinline__ void r3_loads(int item, const unsigned char* ws, R3Regs& R, int tid) {
    const int bh = item >> 6, n = item & 63, b = bh >> 2, h = bh & 3; const int tok0 = b * 8192 + n * 128;
    rt_load(R.rq, ws, (unsigned)WS_Q + (unsigned)((tok0 * 512 + h * 128) * 2), 1024, tid); rt_load(R.rk, ws, (unsigned)WS_K + (unsigned)((tok0 * 512 + h * 128) * 2), 1024, tid);
    rt_load(R.rv, ws, (unsigned)WS_VT + (unsigned)((h * 128 * NT + tok0) * 2), NT * 2, tid); rt_load(R.rs, ws, (unsigned)WS_SPT + (unsigned)((bh * 64 + n) * 16384 * 2), 256, tid);
}
__device__ __forceinline__ void r3_item_pipe(int item, int nxt, R3Regs& R, unsigned char* ws, const float* retw, LAS unsigned char* lds, int w, int lane, int tid) {
    const int bh = item >> 6, n = item & 63, b = bh >> 2, h = bh & 3, fr = lane & 15, fq = lane >> 4; const int tok0 = b * 8192 + n * 128, irow = tok0 + 16 * w + fr;
    const float l2g = log2gamma(h);
    LAS unsigned char* Qs = lds; LAS unsigned char* Ks = lds + RT_TILE; LAS unsigned char* Vs = lds + 2 * RT_TILE; LAS unsigned char* Ss = lds + 3 * RT_TILE;
    rt_store(R.rq, Qs, tid); rt_store(R.rk, Ks, tid); rt_store(R.rv, Vs, tid); rt_store(R.rs, Ss, tid);
    if (nxt >= 0) r3_loads(nxt, ws, R, tid);
    const unsigned goff = (unsigned)WS_G + (unsigned)((irow * 512 + h * 128 + 4 * fq) * 2);
    const unsigned moff = (unsigned)WS_MIX + (unsigned)((irow * 1024 + h * 128 + 4 * fq) * 2);
    u32x2 gv[8];
#pragma unroll
    for (int et = 0; et < 8; ++et) gv[et] = *(const u32x2*)(ws + goff + 32 * et);
    __syncthreads();
    bf16x8 qf[4];
#pragma unroll
    for (int ks = 0; ks < 4; ++ks) qf[ks] = LF16(Qs, 16 * w + fr, 32 * ks + 8 * fq);
    f32x4 s[8];
#pragma unroll
    for (int jt = 0; jt < 8; ++jt) { s[jt] = (f32x4){0.f, 0.f, 0.f, 0.f};
        if (jt <= w) {
#pragma unroll
            for (int ks = 0; ks < 4; ++ks) s[jt] = mfma16(LF16(Ks, 16 * jt + fr, 32 * ks + 8 * fq), qf[ks], s[jt]);
#pragma unroll
            for (int jj = 0; jj < 4; ++jj) { const int dd = 16 * (w - jt) + fr - 4 * fq - jj; s[jt][jj] = dd >= 0 ? s[jt][jj] * exp2f(l2g * (float)dd) : 0.f; } } }
    f32x4 o[8];
#pragma unroll
    for (int et = 0; et < 8; ++et) o[et] = (f32x4){0.f, 0.f, 0.f, 0.f};
#pragma unroll
    for (int kp = 0; kp < 4; ++kp) if (2 * kp <= w) { const bf16x8 sf = __builtin_bit_cast(bf16x8, pk8(s[2 * kp], s[2 * kp + 1]));
#pragma unroll
        for (int et = 0; et < 8; ++et) { const u32x2 v0 = LF8(Vs, 16 * et + fr, 32 * kp + 4 * fq), v1 = LF8(Vs, 16 * et + fr, 32 * kp + 16 + 4 * fq);
            const u32x4 vv = (u32x4){v0.x, v0.y, v1.x, v1.y}; o[et] = mfma16(__builtin_bit_cast(bf16x8, vv), sf, o[et]); } }
    const float wq = exp2f(l2g * (float)(16 * w + fr + 1)); float s1 = 0.f;
#pragma unroll
    for (int et = 0; et < 8; ++et) { f32x4 oc = (f32x4){0.f, 0.f, 0.f, 0.f};
#pragma unroll
        for (int ks = 0; ks < 4; ++ks) oc = mfma16(LF16(Ss, 16 * et + fr, 32 * ks + 8 * fq), qf[ks], oc);
        o[et] = o[et] + wq * oc; s1 += sum4(o[et]); }
    s1 += __shfl_xor(s1, 16); s1 += __shfl_xor(s1, 32); const float mean = s1 * (1.0f / 128.0f); float s2 = 0.f;
#pragma unroll
    for (int et = 0; et < 8; ++et) { o[et] = o[et] - mean; s2 += sumsq4(o[et]); }
    s2 += __shfl_xor(s2, 16); s2 += __shfl_xor(s2, 32);
    const float sc = 1.0f / sqrtf(s2 * (1.0f / 128.0f) + EPS);
    const float* wnp = retw + h * 128 + 4 * fq;
#pragma unroll
    for (int et = 0; et < 8; ++et) { const f32x4 wn = *(const f32x4*)(wnp + 16 * et);
        u32x2 ov; ov.x = pk2(o[et][0] * sc * wn[0] * siluf_(bflo(gv[et].x)), o[et][1] * sc * wn[1] * siluf_(bfhi(gv[et].x))); ov.y = pk2(o[et][2] * sc * wn[2] * siluf_(bflo(gv[et].y)), o[et][3] * sc * wn[3] * siluf_(bfhi(gv[et].y)));
        *(u32x2*)(ws + moff + 32 * et) = ov; }
    __syncthreads();
}

#define XB_TMO      128
#define XB_XCNT(j)  (256  + 64 * (j))
#define XB_XSUB(j)  (1280 + 64 * (j))
#define XB_XGEN(j)  (2304 + 64 * (j))
#define XB_TOP      3328
#define XB_TOPGEN   3392
#define XCD_BAR_WORDS 3456
#define XB_SPIN_CAP (1u << 18)

__device__ __forceinline__ unsigned xb_ld(unsigned* p)              { return __hip_atomic_load(p, __ATOMIC_RELAXED, __HIP_MEMORY_SCOPE_AGENT); }
__device__ __forceinline__ unsigned xb_add(unsigned* p, unsigned v) { return __hip_atomic_fetch_add(p, v, __ATOMIC_RELAXED, __HIP_MEMORY_SCOPE_AGENT); }
__device__ __forceinline__ unsigned xb_xcc_id() { return (unsigned)__builtin_amdgcn_s_getreg((3 << 11) | 20) & 0xFu; }
#define XB_SPIN(cond, bar) do { unsigned _sp = 0; while (cond) { __builtin_amdgcn_s_sleep(1); \
    if ((++_sp & 255u) == 0u) { if (xb_ld(&(bar)[XB_TMO])) break; if (_sp > XB_SPIN_CAP) { atomicAdd(&(bar)[XB_TMO], 1u); break; } } } } while (0)

struct XcdBarrier {
    unsigned* bar; unsigned x;
    volatile LAS unsigned* st;
};

__device__ __forceinline__ XcdBarrier xcd_barrier_post(unsigned* bar, volatile LAS unsigned* st) {
    XcdBarrier b; b.bar = bar; b.x = xb_xcc_id(); b.st = st;
    if (threadIdx.x == 0) (void)xb_add(&bar[XB_XCNT(b.x)], 1u);
    return b;
}
__device__ __forceinline__ void xcd_barrier_complete(unsigned* bar, unsigned x, unsigned& nloc, unsigned& nx) {
    const unsigned G = gridDim.x * gridDim.y * gridDim.z;
    unsigned sum, cnt, mine, sp = 0u;
    for (;;) {
        sum = 0u; cnt = 0u; mine = 0u;
#pragma unroll
        for (unsigned j = 0; j < 16; ++j) { const unsigned c = xb_ld(&bar[XB_XCNT(j)]); sum += c; cnt += (c > 0u) ? 1u : 0u; mine = (j == x) ? c : mine; }
        if (sum == G) break;
        __builtin_amdgcn_s_sleep(1);
        if ((++sp & 255u) == 0u) { if (xb_ld(&bar[XB_TMO])) break; if (sp > XB_SPIN_CAP) { atomicAdd(&bar[XB_TMO], 1u); break; } }
    }
    nloc = mine > 0u ? mine : 1u; nx = cnt > 0u ? cnt : 1u;
}

__device__ __forceinline__ void xcd_barrier(const XcdBarrier& b) {
    asm volatile("s_waitcnt vmcnt(0)" ::: "memory");
    __syncthreads();
    if (threadIdx.x == 0) {
        unsigned* bar = b.bar;
        __builtin_amdgcn_s_waitcnt(0);
        unsigned nloc = b.st[0], nx = b.st[1];
        if (nloc == 0u) { xcd_barrier_complete(bar, b.x, nloc, nx); b.st[0] = nloc; b.st[1] = nx; }
        const unsigned old = xb_add(&bar[XB_XSUB(b.x)], 1u);
        const unsigned gen = old / nloc;
        if (old + 1u == (gen + 1u) * nloc) {
            __builtin_amdgcn_fence(__ATOMIC_RELEASE, "agent");
            asm volatile("s_waitcnt vmcnt(0)" ::: "memory");
            const unsigned og = xb_add(&bar[XB_TOP], 1u);
            const unsigned tg = og / nx;
            if (og + 1u == (tg + 1u) * nx) xb_add(&bar[XB_TOPGEN], 1u);
            else XB_SPIN(xb_ld(&bar[XB_TOPGEN]) == tg, bar);
            __builtin_amdgcn_fence(__ATOMIC_ACQUIRE, "agent");
            xb_add(&bar[XB_XGEN(b.x)], 1u);
            asm volatile("s_waitcnt vmcnt(0)" ::: "memory");
        } else {
            XB_SPIN(xb_ld(&bar[XB_XGEN(b.x)]) == gen, bar);
            __builtin_amdgcn_fence(__ATOMIC_ACQUIRE, "agent");
            asm volatile("s_waitcnt vmcnt(0)" ::: "memory");
        }
    }
    __syncthreads();
}


#define GEMM_PHASE(EpiT, SchedT, g, S, E) pg8::gemm_phase<EpiT, SchedT, true, true>((PG8_LAS unsigned char*)lds, g, S, E)

__global__ void __launch_bounds__(NTHR, 2) hymba_fwd(Args args) {
    extern __shared__ __attribute__((aligned(16))) unsigned char lds_raw[];
    LAS unsigned char* lds = (LAS unsigned char*)lds_raw;
    cg::grid_group grid = cg::this_grid();
    const int tid = threadIdx.x, lane = tid & 63, wave = __builtin_amdgcn_readfirstlane(tid >> 6);
    const int G = gridDim.x, bx = blockIdx.x, vcu = (G % 8 == 0) ? (bx % 8) * (G / 8) + bx / 8 : bx;
    const int gw = vcu * NWAVES + wave, NGW = G * NWAVES, swid = wave * G + vcu;
    const int gtid = vcu * NTHR + tid, NTH = G * NTHR;
    volatile LAS unsigned* xst = (volatile LAS unsigned*)(lds + LDS_BYTES - 16);
    if (tid == 0) { xst[0] = 0u; xst[1] = 0u; }
    __syncthreads();
    XcdBarrier xbar = xcd_barrier_post((unsigned*)(args.ws + WS_BAR), xst);
#ifndef PROBE_A
#define PROBE_A -1
#define PROBE_B -1
#endif
#ifndef PROBE_BX
#define PROBE_BX 0
#endif
    LAS unsigned long long* TS = (LAS unsigned long long*)(lds + LDS_BYTES - 160);
#define STAMP(i) do { if (PROBE_A >= 0 && bx == PROBE_BX && tid == 0) TS[i] = __builtin_amdgcn_s_memrealtime(); } while (0)
    STAMP(0);
    typedef const __attribute__((address_space(4))) Args* KArgP;
#define KA() ({ KArgP _k = (KArgP)__builtin_amdgcn_kernarg_segment_ptr(); asm volatile("" : "+s"(_k)); _k; })
    const int lo = args.ph_lo, hi = args.ph_hi;
#ifndef PHASE_MASK
#define PHASE_MASK 0xffff
#endif
#define IN(k) (((PHASE_MASK >> (k)) & 1) && lo <= (k) && (k) < hi)
#ifndef REP_MASK
#define REP_MASK 0
#endif
#ifndef SYNC_REP
#define SYNC_REP 1
#endif
#define NREP(k) ((((REP_MASK) >> (k)) & 1) ? 2 : 1)
#define SEAM(k) do { if (IN(k) && IN((k) + 1)) { for (int sr = 0; sr < SYNC_REP; ++sr) { if ((k) == 0) grid.sync(); else xcd_barrier(xbar); } } } while (0)
#define SSQ1 ((float*)(ws + WS_SSQ1))
#define SSQ2 ((float*)(ws + WS_SSQ2))
#define SSQ3 ((float*)(ws + WS_SSQ3))
#define SSQG ((float*)(ws + WS_SSQG))
#define N1M ((bf16*)(ws + WS_N1M))
#define GUM ((float*)(ws + WS_GUM))
#define H1MF ((float*)(ws + WS_H1MF))
#define PM ((float*)(ws + WS_PM))
#define ST0 ((float*)(ws + WS_ST0))
#define ZM ((float*)(ws + WS_ZM))
#define A16 ((const f32x2*)(ws + WS_A16))
#define H1B ((bf16*)(ws + WS_H1B))
#define WMAIN ((bf16*)(ws + WS_WMAIN))
#define WKV ((bf16*)(ws + WS_WKV))
#define ROT ((f32x2*)(ws + WS_ROT))
#define ACT ((bf16*)(ws + WS_ACT))
#define Qb ((bf16*)(ws + WS_Q))
#define Kb ((bf16*)(ws + WS_K))
#define Gb ((bf16*)(ws + WS_G))
#define KWT ((bf16*)(ws + WS_KWT))
#define VT ((bf16*)(ws + WS_VT))
#define N1 ((bf16*)(ws + WS_N1))
#define UA ((bf16*)(ws + WS_UA))
#define MIX ((bf16*)(ws + WS_MIX))
#define Zb ((float*)(ws + WS_Z))
#define SPT ((bf16*)(ws + WS_SPT))
#define KVT ((float*)(ws + WS_KVT))
#define Yb ((bf16*)(ws + WS_Y))

    if (IN(0)) for (int rep = 0; rep < NREP(0); ++rep) {
        if (rep) __syncthreads();
        Args a0; { KArgP ka = KA(); for (int i = 0; i < 26; ++i) a0.in[i] = ka->in[i]; a0.out = ka->out; a0.ws = ka->ws; a0.ph_lo = 0; a0.ph_hi = 0; } const Args& args = a0; unsigned char* ws = a0.ws;
        for (int g = vcu; g < 32; g += G) ssm_mats(args, g, lds, tid);
        LAS float* scr = (LAS float*)(lds + wave * 17408);
        {
            const bool split = (G > 32); const bool worker = !split || vcu >= 32;
            const int ww = split ? gw - 32 * NWAVES : gw, WW = split ? NGW - 32 * NWAVES : NGW;
            const int wt = split ? gtid - 32 * NTHR : gtid, WTN = split ? NTH - 32 * NTHR : NTH;
            if (worker) {
                tr_run(args, 0, 12, ww, WW, scr, lane);
                for (int m = ww; m < NT; m += 4 * WW) {
                    if (m + 3 * WW < NT) rms_rows4_to_bf16(args.in[0] + (size_t)m * DM, (size_t)WW * DM, args.in[2], N1 + (size_t)m * DM, (size_t)WW * DM, lane);
                    else for (int q = 0; q < 4; ++q) if (m + q * WW < NT) rms_row_to_bf16(args.in[0] + (size_t)(m + q * WW) * DM, args.in[2], N1 + (size_t)(m + q * WW) * DM, lane);
                }
                if (ww < 16) rms_row_to_bf16(args.in[1] + (size_t)ww * DM, args.in[2], N1M + (size_t)ww * DM, lane);
                {   const int i = wt & 63; const double f = exp2(-(double)i * (13.287712379549449 / 64.0));
                    for (int idx = wt; idx < 8208 * 64; idx += WTN) { const int pos = idx >> 6; double ang = (double)pos * f; ang -= 6.283185307179586 * floor(ang * 0.15915494309189535);
                        float sn, cs; sincosf((float)ang, &sn, &cs); ROT[idx] = (f32x2){cs, sn}; } }
                for (int idx = wt; idx < NT; idx += WTN) { SSQ1[idx] = 0.f; SSQ2[idx] = 0.f; SSQ3[idx] = 0.f; SSQG[idx] = 0.f; }
                for (int idx = wt; idx < 16 * 1024; idx += WTN) H1MF[idx] = args.in[1][idx];
                for (int idx = wt; idx < 16 * 1536; idx += WTN) PM[idx] = 0.f;
            }
        }
    }
    STAMP(13);
    SEAM(0);
    STAMP(1);
    if (IN(1)) for (int rep = 0; rep < NREP(1); ++rep) {
        if (rep) __syncthreads();
        KArgP ka = KA(); unsigned char* ws = ka->ws;
        if (bx >= G / 2) skinny((const bf16*)(ws + WS_WGU1), DM, 352, 1, DM, wave * (G - G / 2) + (bx - G / 2), NWAVES * (G - G / 2), ALBf16{N1M, DM}, EPStore{GUM, 5632}, lane);
        pg8::Gemm g{N1, (const bf16*)(ws + WS_WGU1), DM, DM, DM}; pg8::StaticOrder S; S.init(NT, 5632, G, bx);
        EpiSwiGLU E{ACT, nullptr};
        GEMM_PHASE(EpiSwiGLU, pg8::StaticOrder, g, S, E);
    }
    SEAM(1);
    STAMP(2);
    if (IN(2)) for (int rep = 0; rep < NREP(2); ++rep) {
        if (rep) __syncthreads();
        KArgP ka = KA(); unsigned char* ws = ka->ws;
        skinny((const bf16*)(ws + WS_WD1), FF, 64, 22, FF, swid, NGW, ALSwiGLU{GUM}, EPAtomic{H1MF, 1024, 0.5f}, lane);
        pg8::Gemm g{ACT, (const bf16*)(ws + WS_WD1), FF, FF, FF}; pg8::StaticOrder S; S.init(NT, DM, G, bx);
        EpiRes<0> E{ka->in[0], ka->out, H1B, SSQ1, nullptr};
        GEMM_PHASE(EpiRes<0>, pg8::StaticOrder, g, S, E);
    }
    SEAM(2);
    STAMP(3);
    if (IN(3)) for (int rep = 0; rep < NREP(3); ++rep) {
        if (rep) __syncthreads();
        KArgP ka = KA(); unsigned char* ws = ka->ws;
        skinny(WMAIN + (size_t)512 * DM, DM, 32, 8, DM, swid, NGW, ALF32{H1MF, DM}, EPAtomic{PM, 1536, 1.0f}, lane);
        skinny(WKV + (size_t)512 * DM, DM, 32, 8, DM, (swid + NGW - 256) % NGW, NGW, ALF32{H1MF, DM}, EPAtomic{PM + 512, 1536, 1.0f}, lane);
        skinny(WMAIN + (size_t)1536 * DM, DM, 32, 8, DM, (swid + NGW - 512) % NGW, NGW, ALF32{H1MF, DM}, EPAtomic{PM + 1024, 1536, 1.0f}, lane);
        pg8::Gemm g{H1B, WMAIN, DM, DM, DM}; P3Order S{G, vcu};
        EpiInProj E{SSQ1, ROT, Qb, Kb, Gb, UA, KWT, VT};
        GEMM_PHASE(EpiInProj, P3Order, g, S, E);
    }
    SEAM(3);
    STAMP(4);
    if (IN(4)) for (int rep = 0; rep < NREP(4); ++rep) {
        if (rep) __syncthreads();
        KArgP ka = KA(); unsigned char* ws = ka->ws;
        const int nhalf = G / 2;
        if (vcu >= nhalf) {
            LAS float* rs1 = (LAS float*)lds;
            for (int r = wave * 2; r < wave * 2 + 2; ++r) { float s = 0.f; for (int c = lane; c < DM; c += 64) { const float v = H1MF[r * DM + c]; s += v * v; } s = wave_sum(s); if (lane == 0) rs1[r] = 1.0f / sqrtf(s * (1.0f / 1024.0f) + EPS); }
            __syncthreads();
            const int sb = vcu - nhalf, nsb = G - nhalf;
            for (int o = sb * NTHR + tid; o < 65536; o += nsb * NTHR) { const int h = o >> 14, e = (o >> 7) & 127, d = o & 127, i = d & 63; const float l2g = log2gamma(h); float acc = 0.f;
#pragma unroll
                for (int j = 0; j < 16; ++j) { const float r = rs1[j]; const float x1 = PM[j * 1536 + 256 * (h >> 1) + 64 * (h & 1) + i], x2 = PM[j * 1536 + 256 * (h >> 1) + 64 * (h & 1) + i + 128]; const f32x2 cs = ROT[j * 64 + i];
                    const float kd = (d < 64) ? (x1 * cs.x - x2 * cs.y) : (x1 * cs.y + x2 * cs.x); acc += exp2f(l2g * (float)(15 - j)) * kd * PM[j * 1536 + 512 + h * 128 + e] * (r * r * 0.08838834764831845f); }
                ST0[o] = acc; }
            for (int o = sb * NWAVES + wave; o < 4096; o += nsb * NWAVES) {
                const int g = o >> 7, r = o & 127; const bf16* wz = (const bf16*)(ws + WS_WZ) + (size_t)(g * 256 + r) * 256; float acc = 0.f;
#pragma unroll
                for (int k = 0; k < 4; ++k) { const int c = lane + 64 * k; acc += bf2f(wz[c]) * PM[(c >> 4) * 1536 + 1024 + g * 16 + (c & 15)] * rs1[c >> 4]; }
                acc = wave_sum(acc); if (lane == 0) ZM[o] = acc; }
            __syncthreads();
        }
        {   R1Regs R1;
            if (G == 256) { if (vcu >= 128) { const int i0 = vcu - 128; r1_loads(i0, ws, R1, tid);
                                r1_item_pipe(i0, i0 + 128, R1, ws, lds, wave, lane, tid); r1_item_pipe(i0 + 128, i0 + 256, R1, ws, lds, wave, lane, tid); r1_item_pipe(i0 + 256, -1, R1, ws, lds, wave, lane, tid); }
                            else { r1_loads(384 + vcu, ws, R1, tid); r1_item_pipe(384 + vcu, -1, R1, ws, lds, wave, lane, tid); } }
            else for (int it = vcu; it < 512; it += G) { r1_loads(it, ws, R1, tid); r1_item_pipe(it, -1, R1, ws, lds, wave, lane, tid); }
        }
        __syncthreads();
        int kdyn = 256; asm volatile("" : "+s"(kdyn)); pg8::Gemm g{UA, (const bf16*)(ws + WS_WZ), kdyn, 384, 256}; GroupOrder S{G, vcu};
        EpiZ E{Zb};
        GEMM_PHASE(EpiZ, GroupOrder, g, S, E);
    }
    SEAM(4);
    STAMP(5);
    if (IN(6)) for (int rep = 0; rep < NREP(6); ++rep) {
        if (rep) __syncthreads();
        KArgP ka = KA(); unsigned char* ws = ka->ws;
        if (rep == 0) {
        for (int L = vcu; L < 128; L += G) {
            const int g = L >> 2, rt = L & 3, b = rt >> 1, half = rt & 1, n = lane; const f32x2 a16 = A16[g * 64 + n];
            LAS f32x2* T = (LAS f32x2*)lds;
            const float* zb = Zb + ((size_t)g * 1024 + b * 512) * 128 + n;
            float zr[32], zi[32];
            for (int sg = wave; sg < 8 + 8 * half; sg += 8) { f32x2 X = (f32x2){0.f, 0.f};
#pragma unroll
                for (int c = 0; c < 32; ++c) { zr[c] = zb[(size_t)(sg * 32 + c) * 128]; zi[c] = zb[(size_t)(sg * 32 + c) * 128 + 64]; }
#pragma unroll
                for (int c = 0; c < 32; ++c) { const f32x2 t = cmul(a16, X); X = (f32x2){t.x + zr[c], t.y + zi[c]}; }
                T[sg * 64 + n] = X; }
            __syncthreads();
            f32x2 a512 = a16;
#pragma unroll
            for (int q = 0; q < 5; ++q) a512 = cmul(a512, a512);
            { const int sg = half * 8 + wave; f32x2 X = (f32x2){ZM[g * 128 + n], ZM[g * 128 + 64 + n]};
                for (int s2 = 0; s2 < sg; ++s2) { const f32x2 t = cmul(a512, X), tt = T[s2 * 64 + n]; X = (f32x2){t.x + tt.x, t.y + tt.y}; }
                bf16* xo = UA + ((size_t)g * 1024 + b * 512 + sg * 32) * 384 + 256 + n;
                {
#pragma unroll
                    for (int c = 0; c < 32; ++c) { xo[(size_t)c * 384] = (bf16)(pk2(X.x, 0.f) & 0xffffu); xo[(size_t)c * 384 + 64] = (bf16)(pk2(X.y, 0.f) & 0xffffu);
                        const f32x2 t = cmul(a16, X); X = (f32x2){t.x + zr[c], t.y + zi[c]}; } } }
            asm volatile("s_waitcnt vmcnt(0)" ::: "memory");
            __syncthreads();
        }
        {
            const bool all = (G <= 128); const int t0 = all ? gtid : gtid - 128 * NTHR, tn = all ? NTH : NTH - 128 * NTHR;
            if (all || vcu >= 128)
            for (int idx = t0; idx < 8 * 16384; idx += tn) { const int bh = idx >> 14, ed = idx & 16383, h = bh & 3; const float gch = exp2f(128.0f * log2gamma(h)); float S = ST0[h * 16384 + ed];
                const float* kv = KVT + (size_t)bh * 64 * 16384 + ed; bf16* sp = SPT + (size_t)bh * 64 * 16384 + ed;
                { float v[64];
#pragma unroll
                    for (int c = 0; c < 64; ++c) v[c] = kv[(size_t)c * 16384];
#pragma unroll
                    for (int c = 0; c < 64; ++c) { sp[(size_t)c * 16384] = (bf16)(pk2(S, 0.f) & 0xffffu); S = gch * S + v[c]; } } }
        }
        }
        STAMP(14);
        if (rep == 0) {
            Args a0; { for (int i = 0; i < 26; ++i) a0.in[i] = ka->in[i]; a0.out = nullptr; a0.ws = ws; a0.ph_lo = 0; a0.ph_hi = 0; }
            LAS float* scr = (LAS float*)(lds + wave * 17408); const int tw0 = gw, tnw = NGW;
            if (G == 256) {
                constexpr int NSPLIT = 1542;
                if (vcu >= 128) tr_run(a0, 12, NJOBS, gw - 128 * NWAVES, 128 * NWAVES, scr, lane, NSPLIT);
                else tr_run(a0, 12, NJOBS, NSPLIT + gw, 128 * NWAVES, scr, lane);
            } else tr_run(a0, 12, NJOBS, tw0, tnw, scr, lane);
            __syncthreads();
        }
        STAMP(15);
        int kdyn = 384; asm volatile("" : "+s"(kdyn)); pg8::Gemm g{UA, (const bf16*)(ws + WS_WY), kdyn, 384, 384}; GroupOrder S{G, vcu};
        EpiY E{UA, ka->in[16], Yb};
        GEMM_PHASE(EpiY, GroupOrder, g, S, E);
    }
    SEAM(6);
    STAMP(7);
    if (IN(7)) for (int rep = 0; rep < NREP(7); ++rep) {
        if (rep) __syncthreads();
        KArgP ka = KA(); unsigned char* ws = ka->ws;
        if (rep == 0) {
            R3Regs R;
            if (G == 256) {
                if (bx >= 128) { const int i0 = bx - 128; r3_loads(i0, ws, R, tid);
                    r3_item_pipe(i0, i0 + 128, R, ws, ka->in[8], lds, wave, lane, tid); r3_item_pipe(i0 + 128, i0 + 256, R, ws, ka->in[8], lds, wave, lane, tid); r3_item_pipe(i0 + 256, -1, R, ws, ka->in[8], lds, wave, lane, tid); }
                else { r3_loads(384 + bx, ws, R, tid); r3_item_pipe(384 + bx, -1, R, ws, ka->in[8], lds, wave, lane, tid); }
            } else for (int it = vcu; it < 512; it += G) { r3_loads(it, ws, R, tid); r3_item_pipe(it, -1, R, ws, ka->in[8], lds, wave, lane, tid); }
        }
        pg8::Gemm g{Yb, (const bf16*)(ws + WS_WGLU), 512, 512, 512}; pg8::StaticOrder S; S.init(NT, 512, G, bx);
        EpiGLU E{Yb, ka->in[18], MIX, SSQG};
        GEMM_PHASE(EpiGLU, pg8::StaticOrder, g, S, E);
    }
    SEAM(8);
    STAMP(9);
    if (IN(9)) for (int rep = 0; rep < NREP(9); ++rep) {
        if (rep) __syncthreads();
        KArgP ka = KA(); unsigned char* ws = ka->ws; float* outp = ka->out;
        pg8::Gemm g{MIX, (const bf16*)(ws + WS_WOUT), DM, DM, DM}; pg8::StaticOrder S; S.init(NT, DM, G, bx);
        EpiRes<1> E{outp, outp, H1B, SSQ2, SSQG};
        GEMM_PHASE(EpiRes<1>, pg8::StaticOrder, g, S, E);
    }
    SEAM(9);
    STAMP(10);
    if (IN(10)) for (int rep = 0; rep < NREP(10); ++rep) {
        if (rep) __syncthreads();
        KArgP ka = KA(); unsigned char* ws = ka->ws;
        pg8::Gemm g{H1B, (const bf16*)(ws + WS_WGU2), DM, DM, DM}; pg8::StaticOrder S; S.init(NT, 5632, G, bx);
        EpiSwiGLU E{ACT, SSQ2};
        GEMM_PHASE(EpiSwiGLU, pg8::StaticOrder, g, S, E);
    }
    SEAM(10);
    STAMP(11);
    if (IN(11)) for (int rep = 0; rep < NREP(11); ++rep) {
        if (rep) __syncthreads();
        KArgP ka = KA(); unsigned char* ws = ka->ws; float* outp = ka->out;
        pg8::Gemm g{ACT, (const bf16*)(ws + WS_WD2), FF, FF, FF}; pg8::StaticOrder S; S.init(NT, DM, G, bx);
        EpiFinal E{outp, outp, SSQ3, (unsigned*)(ws + WS_BAR + 16 * KiB), ka->in[25]};
        GEMM_PHASE(EpiFinal, pg8::StaticOrder, g, S, E);
    }
    STAMP(12);
    if (PROBE_A >= 0 && bx == PROBE_BX && tid == 0) {
        const unsigned long long d = TS[PROBE_B] - TS[PROBE_A], t0 = __builtin_amdgcn_s_memrealtime();
        while (__builtin_amdgcn_s_memrealtime() - t0 < 4ull * d) __builtin_amdgcn_s_sleep(8);
    }
#undef IN
#undef SEAM
}

#ifndef MK_PER_PHASE
#define MK_PER_PHASE 0
#endif
constexpr int NPHASES = 13;
extern "C" void kernel_launch(void* const* d_in, const int* in_sizes, int n_in, void* d_out, int out_size, void* d_ws, size_t ws_size, hipStream_t stream) {
    static int grid = 0;
    if (grid == 0) {
        if (n_in != 26 || out_size != NT * DM || ws_size < WS_END) { fprintf(stderr, "kernel_launch: unexpected shapes (n_in %d, out %d, ws %zu)\n", n_in, out_size, ws_size); grid = -1; return; }
        int dev = 0, cus = 0, per_cu = 0;
        hipGetDevice(&dev); hipDeviceGetAttribute(&cus, hipDeviceAttributeMultiprocessorCount, dev);
        if (hipFuncSetAttribute((const void*)hymba_fwd, hipFuncAttributeMaxDynamicSharedMemorySize, LDS_BYTES) != hipSuccess) { fprintf(stderr, "kernel_launch: hipFuncSetAttribute failed\n"); grid = -1; return; }
        if (hipOccupancyMaxActiveBlocksPerMultiprocessor(&per_cu, (const void*)hymba_fwd, NTHR, LDS_BYTES) != hipSuccess || per_cu < 1) { fprintf(stderr, "kernel_launch: occupancy query failed (%d)\n", per_cu); (void)hipGetLastError(); per_cu = 1; }
        grid = cus * 1;
        fprintf(stderr, "kernel_launch: grid %d (per_cu %d), ws %zu\n", grid, per_cu, ws_size);
    }
    if (grid < 0) return;
    Args a{};
    for (int i = 0; i < 26; ++i) a.in[i] = (const float*)d_in[i];
    a.out = (float*)d_out; a.ws = (unsigned char*)d_ws;
    if (hipMemsetAsync((char*)d_ws + WS_BAR, 0, BAR_BYTES, stream) != hipSuccess) { fprintf(stderr, "kernel_launch: memset of barrier words failed\n"); return; }
#if MK_PER_PHASE
    for (int p = 0; p < NPHASES; ++p) { a.ph_lo = p; a.ph_hi = p + 1; hipLaunchKernelGGL(hymba_fwd, dim3(grid), dim3(NTHR), LDS_BYTES, stream, a); }
#else
    a.ph_lo = 0; a.ph_hi = NPHASES;
    void* kargs[] = {&a};
    hipError_t e = hipLaunchCooperativeKernel((const void*)hymba_fwd, dim3(grid), dim3(NTHR), kargs, LDS_BYTES, stream);
    if (e != hipSuccess) fprintf(stderr, "kernel_launch: cooperative launch failed: %s (grid %d)\n", hipGetErrorString(e), grid);
#endif
}
```
